# Optimizing an MI355X kernel written in HIP

```python
import math
import jax, jax.numpy as jnp
from jax import lax
import numpy as np

D_MODEL = 1024
BATCH = 8
SEQ = 2048
DEPTH = 2

HALF = D_MODEL // 2
HGRN_HEADS = 4
HGRN_DIM = HALF // HGRN_HEADS
HGRN_CHUNK = 64
FOX_HEADS = 8
FOX_DIM = HALF // FOX_HEADS
LRU_WIDTH = HALF
LRU_BLOCKS = 8
LRU_BLOCK_DIM = LRU_WIDTH // LRU_BLOCKS
LRU_C = 8.0
CONV_WIDTH = 4
SB_HEADS = 8
SB_DIM = HALF // SB_HEADS
Q_BLOCK = 128
D_FF = -(-8 * D_MODEL // (3 * 256)) * 256
N_EVEN = (DEPTH + 1) // 2
N_ODD = DEPTH // 2
ALPHA = (2 * DEPTH) ** 0.25
BETA = (8 * DEPTH) ** -0.25
EVEN_IN = 7 * HALF + FOX_HEADS
ODD_IN = 2 * LRU_WIDTH + 3 * HALF
EPS = 1e-5

kernel_name = 'hybrid_hgrn2_fox_rglru_stickbreaking'


def layer_norm(x, g, b):
    xf = x.astype(jnp.float32)
    mu = jnp.mean(xf, axis=-1, keepdims=True)
    xc = xf - mu
    var = jnp.mean(xc * xc, axis=-1, keepdims=True)
    y = xc * lax.rsqrt(var + EPS) * g.astype(jnp.float32) + b.astype(jnp.float32)
    return y.astype(x.dtype)


def rms_norm_f32(x, g):
    xf = x.astype(jnp.float32)
    return xf * lax.rsqrt(jnp.mean(xf * xf, axis=-1, keepdims=True) + EPS) * g.astype(jnp.float32)


def split_cols(t, sizes):
    return jnp.split(t, np.cumsum(sizes)[:-1].tolist(), axis=-1)


def hgrn2(q, f_logit, inp, g, lb, norm_g):
    B, S, _ = q.shape
    nc = S // HGRN_CHUNK
    z = f_logit.astype(jnp.float32)
    log_f = jnp.log(lb + (1.0 - lb) * jax.nn.sigmoid(z))
    k = (1.0 - lb) * jax.nn.sigmoid(-z)

    def to_chunks(t):
        return t.astype(jnp.float32).reshape(B, nc, HGRN_CHUNK, HGRN_HEADS, HGRN_DIM).transpose(1, 0, 3, 2, 4)

    qc, kc, vc, lc = to_chunks(q), to_chunks(k), to_chunks(inp), to_chunks(log_f)
    causal = jnp.tril(jnp.ones((HGRN_CHUNK, HGRN_CHUNK), dtype=bool))[:, :, None]

    def step(state, chunk):
        qt, kt, vt, lt = chunk
        b = jnp.cumsum(lt, axis=2)
        o_inter = jnp.einsum('bhtk,bhkv->bhtv', qt * jnp.exp(b), state)
        rel = b[:, :, :, None, :] - b[:, :, None, :, :]
        decay = jnp.exp(jnp.where(causal, rel, -jnp.inf))
        scores = jnp.einsum('bhtk,bhtsk,bhsk->bhts', qt, decay, kt)
        o = o_inter + jnp.einsum('bhts,bhsv->bhtv', scores, vt)
        b_last = b[:, :, -1:, :]
        state = jnp.exp(b_last[:, :, 0, :])[..., None] * state + jnp.einsum(
            'bhsk,bhsv->bhkv', kt * jnp.exp(b_last - b), vt)
        return state, o

    s0 = jnp.zeros((B, HGRN_HEADS, HGRN_DIM, HGRN_DIM), jnp.float32)
    _, o = lax.scan(step, s0, (qc, kc, vc, lc))
    o = o.transpose(1, 0, 3, 2, 4).reshape(B, S, HGRN_HEADS, HGRN_DIM)
    o = rms_norm_f32(o, norm_g)
    gate = jax.nn.silu(g.astype(jnp.float32)).reshape(B, S, HGRN_HEADS, HGRN_DIM)
    return (o * gate).reshape(B, S, HALF).astype(g.dtype)


def forgetting_attention(q, k, v, f_logit, b_f):
    B, S, _ = q.shape
    q = q.reshape(B, S, FOX_HEADS, FOX_DIM)
    k = k.reshape(B, S, FOX_HEADS, FOX_DIM)
    v = v.reshape(B, S, FOX_HEADS, FOX_DIM)
    log_f = jax.nn.log_sigmoid(f_logit.astype(jnp.float32) + b_f.astype(jnp.float32))
    c = jnp.cumsum(log_f, axis=1).transpose(0, 2, 1)
    scale = FOX_DIM ** -0.5
    outs = []
    for blk in range(S // Q_BLOCK):
        q0, q1 = blk * Q_BLOCK, (blk + 1) * Q_BLOCK
        logits = jnp.einsum('bqhd,bkhd->bhqk', q[:, q0:q1], k[:, :q1]).astype(jnp.float32) * scale
        logits = logits + c[:, :, q0:q1, None] - c[:, :, None, :q1]
        qpos = jnp.arange(q0, q1)[:, None]
        kpos = jnp.arange(q1)[None, :]
        logits = jnp.where(kpos <= qpos, logits, -jnp.inf)
        p = jax.nn.softmax(logits, axis=-1)
        outs.append(jnp.einsum('bhqk,bkhd->bqhd', p.astype(v.dtype), v[:, :q1]))
    return jnp.concatenate(outs, axis=1).reshape(B, S, HALF)


def stick_breaking_attention(q, k, v):
    B, S, _ = q.shape
    q = q.reshape(B, S, SB_HEADS, SB_DIM)
    k = k.reshape(B, S, SB_HEADS, SB_DIM)
    v = v.reshape(B, S, SB_HEADS, SB_DIM)
    scale = SB_DIM ** -0.5
    outs = []
    for blk in range(S // Q_BLOCK):
        q0, q1 = blk * Q_BLOCK, (blk + 1) * Q_BLOCK
        z = jnp.einsum('bqhd,bkhd->bhqk', q[:, q0:q1], k[:, :q1]).astype(jnp.float32) * scale
        qpos = jnp.arange(q0, q1)[:, None]
        kpos = jnp.arange(q1)[None, :]
        mask = kpos < qpos
        log_one_minus = jnp.where(mask, jax.nn.log_sigmoid(-z), 0.0)
        suffix = lax.cumsum(log_one_minus, axis=3, reverse=True) - log_one_minus
        log_w = jax.nn.log_sigmoid(z) + suffix
        w = jnp.where(mask, jnp.exp(log_w), 0.0)
        outs.append(jnp.einsum('bhqk,bkhd->bqhd', w.astype(v.dtype), v[:, :q1]))
    return jnp.concatenate(outs, axis=1).reshape(B, S, HALF)


def rg_lru_branch(xr, gate, conv_w, conv_b, wa, ba, wx, bx, lam):
    B, S, W = xr.shape
    xpad = jnp.pad(xr, ((0, 0), (CONV_WIDTH - 1, 0), (0, 0)))
    xc = conv_b + sum(conv_w[j] * xpad[:, j:j + S] for j in range(CONV_WIDTH))
    xb = xc.reshape(B, S, LRU_BLOCKS, LRU_BLOCK_DIM)
    r = jax.nn.sigmoid(jnp.einsum('bsni,nij->bsnj', xb, wa).reshape(B, S, W) + ba)
    i = jax.nn.sigmoid(jnp.einsum('bsni,nij->bsnj', xb, wx).reshape(B, S, W) + bx)
    log_a = -LRU_C * r.astype(jnp.float32) * jax.nn.softplus(-lam.astype(jnp.float32))
    a = jnp.exp(log_a)
    u = jnp.sqrt(-jnp.expm1(2.0 * log_a)) * (i * xc).astype(jnp.float32)

    def combine(left, right):
        a1, b1 = left
        a2, b2 = right
        return a1 * a2, a2 * b1 + b2

    _, h = lax.associative_scan(combine, (a, u), axis=1)
    return (h * jax.nn.gelu(gate.astype(jnp.float32), approximate=True)).astype(xr.dtype)


def swiglu(x, w13, w2):
    a, b = jnp.split(x @ w13, 2, axis=-1)
    return (jax.nn.silu(a) * b) @ w2


def setup_inputs(seed: int = 0) -> dict:
    key = jax.random.key(seed)
    ks = jax.random.split(key, 24)
    f32 = jnp.float32
    nrm = lambda k, shp, s: jax.random.normal(k, shp, f32) * s
    x = jax.random.normal(ks[0], (BATCH, SEQ, D_MODEL), f32)
    ev_w_in = nrm(ks[1], (N_EVEN, D_MODEL, EVEN_IN), D_MODEL ** -0.5)
    ev_fox_bf = 1.0 + nrm(ks[2], (N_EVEN, FOX_HEADS), 0.1)
    hgrn_lb = nrm(ks[3], (DEPTH + 1, HALF), 0.1)
    ev_hgrn_norm_g = 1.0 + nrm(ks[4], (N_EVEN, HGRN_DIM), 0.02)
    ev_w_out = nrm(ks[5], (N_EVEN, D_MODEL, D_MODEL), BETA * D_MODEL ** -0.5)
    od_w_in = nrm(ks[6], (N_ODD, D_MODEL, ODD_IN), D_MODEL ** -0.5)
    od_conv_w = nrm(ks[7], (N_ODD, CONV_WIDTH, LRU_WIDTH), CONV_WIDTH ** -0.5)
    od_conv_b = nrm(ks[8], (N_ODD, LRU_WIDTH), 0.02)
    od_gate_a_w = nrm(ks[9], (N_ODD, LRU_BLOCKS, LRU_BLOCK_DIM, LRU_BLOCK_DIM), LRU_BLOCK_DIM ** -0.5)
    od_gate_a_b = nrm(ks[10], (N_ODD, LRU_WIDTH), 0.02)
    od_gate_x_w = nrm(ks[11], (N_ODD, LRU_BLOCKS, LRU_BLOCK_DIM, LRU_BLOCK_DIM), LRU_BLOCK_DIM ** -0.5)
    od_gate_x_b = nrm(ks[12], (N_ODD, LRU_WIDTH), 0.02)
    a_c = jax.random.uniform(ks[13], (N_ODD, LRU_WIDTH), f32, 0.9, 0.999) ** (1.0 / LRU_C)
    od_lru_lambda = jnp.log(a_c) - jnp.log1p(-a_c)
    od_w_out = nrm(ks[14], (N_ODD, D_MODEL, D_MODEL), BETA * D_MODEL ** -0.5)
    ffn_w13 = nrm(ks[15], (DEPTH, D_MODEL, 2 * D_FF), D_MODEL ** -0.5)
    ffn_w2 = nrm(ks[16], (DEPTH, D_FF, D_MODEL), BETA * D_FF ** -0.5)
    ln_g = 1.0 + nrm(ks[17], (DEPTH, 2, D_MODEL), 0.02)
    ln_b = nrm(ks[18], (DEPTH, 2, D_MODEL), 0.02)
    return {'x': x, 'ev_w_in': ev_w_in, 'ev_fox_bf': ev_fox_bf, 'hgrn_lb': hgrn_lb,
            'ev_hgrn_norm_g': ev_hgrn_norm_g, 'ev_w_out': ev_w_out, 'od_w_in': od_w_in,
            'od_conv_w': od_conv_w, 'od_conv_b': od_conv_b, 'od_gate_a_w': od_gate_a_w,
            'od_gate_a_b': od_gate_a_b, 'od_gate_x_w': od_gate_x_w, 'od_gate_x_b': od_gate_x_b,
            'od_lru_lambda': od_lru_lambda, 'od_w_out': od_w_out, 'ffn_w13': ffn_w13,
            'ffn_w2': ffn_w2, 'ln_g': ln_g, 'ln_b': ln_b}


def reference(x, ev_w_in, ev_fox_bf, hgrn_lb, ev_hgrn_norm_g, ev_w_out, od_w_in, od_conv_w,
              od_conv_b, od_gate_a_w, od_gate_a_b, od_gate_x_w, od_gate_x_b, od_lru_lambda,
              od_w_out, ffn_w13, ffn_w2, ln_g, ln_b):
    lb_all = jnp.cumsum(jax.nn.softmax(hgrn_lb.astype(jnp.float32), axis=0), axis=0)
    for layer in range(DEPTH):
        if layer % 2 == 0:
            e = layer // 2
            proj = x @ ev_w_in[e]
            qa, fa, ia, ga, qb, kb, vb, fb = split_cols(proj, [HALF] * 7 + [FOX_HEADS])
            ya = hgrn2(qa, fa, ia, ga, lb_all[layer], ev_hgrn_norm_g[e])
            yb = forgetting_attention(qb, kb, vb, fb, ev_fox_bf[e])
            mix = jnp.concatenate([ya, yb], axis=-1) @ ev_w_out[e]
        else:
            o = layer // 2
            proj = x @ od_w_in[o]
            xr, gr, qd, kd, vd = split_cols(proj, [LRU_WIDTH, LRU_WIDTH, HALF, HALF, HALF])
            yc = rg_lru_branch(xr, gr, od_conv_w[o], od_conv_b[o], od_gate_a_w[o], od_gate_a_b[o],
                               od_gate_x_w[o], od_gate_x_b[o], od_lru_lambda[o])
            yd = stick_breaking_attention(qd, kd, vd)
            mix = jnp.concatenate([yc, yd], axis=-1) @ od_w_out[o]
        x = layer_norm(ALPHA * x + mix, ln_g[layer, 0], ln_b[layer, 0])
        x = layer_norm(ALPHA * x + swiglu(x, ffn_w13[layer], ffn_w2[layer]), ln_g[layer, 1], ln_b[layer, 1])
    return x
```

```cpp
#include <hip/hip_runtime.h>
#include <hip/hip_cooperative_groups.h>
#include <cstdio>
#include <cstdint>
namespace cg = cooperative_groups;
#define LAS __attribute__((address_space(3)))
typedef unsigned short bf16_t;
typedef short bf16x8 __attribute__((ext_vector_type(8)));
typedef short s16x4 __attribute__((ext_vector_type(4)));
typedef float f32x4 __attribute__((ext_vector_type(4)));
typedef float f32x16 __attribute__((ext_vector_type(16)));
typedef unsigned u32x4 __attribute__((ext_vector_type(4)));
typedef unsigned u32x2 __attribute__((ext_vector_type(2)));
typedef float f32x2_t __attribute__((ext_vector_type(2)));
typedef __bf16 bf16x2_t __attribute__((ext_vector_type(2)));

constexpr int NB = 8, SEQ = 2048, DM = 1024, MROWS = NB * SEQ;
constexpr int EVEN_IN = 3592, EVEN_N = 3584, ODD_IN = 2560, DFF = 2816, DFF2 = 5632;
constexpr float ALPHA = 1.41421356237309515f;
constexpr float LN_EPS = 1e-5f;
constexpr float LOG2E = 1.4426950408889634f;
constexpr float QK_C2 = 0.125f * 1.4426950408889634f;

constexpr size_t MiB = 1u << 20;
constexpr size_t WS_CTL = 0, CTL_ZERO_BYTES = 4096;
constexpr size_t WS_WIN0 = 2 * MiB, WS_WOUT0 = 9 * MiB, WS_WIN1 = 11 * MiB, WS_WOUT1 = 16 * MiB, WS_W13 = 18 * MiB, WS_W2 = 40 * MiB;
constexpr size_t W13_BYTES = (size_t)DFF2 * DM * 2, W2_BYTES = (size_t)DM * DFF * 2;
constexpr size_t WS_FB = 51 * MiB, WS_XB = 52 * MiB, WS_YCAT = 84 * MiB, WS_PROJ = 116 * MiB, WS_LRU_U = 196 * MiB, WS_END = 228 * MiB;
constexpr int LDS_MISC = 131072, LDS_BYTES = 132096;

__device__ __forceinline__ unsigned cvtpk(float lo, float hi) { f32x2_t v = {lo, hi}; bf16x2_t b = __builtin_convertvector(v, bf16x2_t); return __builtin_bit_cast(unsigned, b); }
__device__ __forceinline__ float bf2f(unsigned short x) { return __uint_as_float(((unsigned)x) << 16); }
__device__ __forceinline__ float bflo(unsigned x) { return __uint_as_float(x << 16); }
__device__ __forceinline__ float bfhi(unsigned x) { return __uint_as_float(x & 0xffff0000u); }
__device__ __forceinline__ float ex2(float x) { return __builtin_amdgcn_exp2f(x); }
__device__ __forceinline__ float lg2(float x) { return __builtin_amdgcn_logf(x); }
__device__ __forceinline__ float frcp(float x) { return __builtin_amdgcn_rcpf(x); }
__device__ __forceinline__ int crow(int i, int hi) { return (i & 3) + 8 * (i >> 2) + 4 * hi; }
__device__ __forceinline__ float wave_sum(float v) {
#pragma unroll
    for (int o = 1; o < 64; o <<= 1) v += __shfl_xor(v, o);
    return v;
}
__device__ __forceinline__ s16x4 vtr(const LAS char* p) { return __builtin_bit_cast(s16x4, __builtin_amdgcn_ds_read_tr16_b64_v4i16((LAS s16x4*)p)); }
__device__ __forceinline__ bf16x8 pack8(const f32x16& p, int b) {
    u32x4 w; w.x = cvtpk(p[b], p[b + 1]); w.y = cvtpk(p[b + 2], p[b + 3]); w.z = cvtpk(p[b + 4], p[b + 5]); w.w = cvtpk(p[b + 6], p[b + 7]);
    return __builtin_bit_cast(bf16x8, w);
}
#define MFMA32(a, b, c) __builtin_amdgcn_mfma_f32_32x32x16_bf16((a), (b), (c), 0, 0, 0)
namespace pg8 {
#define PG8_LAS __attribute__((address_space(3)))
typedef unsigned short bf16_t;
typedef short bf16x8 __attribute__((ext_vector_type(8)));
typedef float f32x4 __attribute__((ext_vector_type(4)));
typedef unsigned u32x4 __attribute__((ext_vector_type(4)));
constexpr int BM = 256, BK = 64, HALF = 128, HTB = HALF * BK * 2  , STAGE_BYTES = 8 * HTB, NXCD = 8, WGM = 8;

__host__ __device__ __forceinline__ int lds_byte(int r, int c) { const int st = (r >> 4) * 2 + (c >> 5), rr = r & 15, cc = c & 31, ob = rr * 64 + cc * 2; return st * 1024 + (ob ^ (((ob >> 9) & 1) << 5)); }
__host__ __device__ __forceinline__ void stage_rc(int b, int& R, int& C) { const int st = b / 1024, sb = b % 1024, swz = sb ^ (((sb >> 9) & 1) << 5); R = (st >> 1) * 16 + swz / 64; C = (st & 1) * 32 + (swz % 64) / 2; }
__host__ __device__ __forceinline__ int perm32(int rho) { const int n = rho >> 4, i = rho & 15; return 8 * (i >> 2) + 4 * n + (i & 3); }

struct Unit { int pm, pn; };
struct Gemm { const bf16_t* A; const bf16_t* Bt; int M, N, K; };

struct StaticOrder {
    int nM, nN, nwg, G, c;
    __host__ __device__ void init(int M, int N, int G_, int c_) { nM = M / BM; nN = N / BM; nwg = nM * nN; G = G_; c = c_; }
    __host__ __device__ bool next(int i, Unit& u) const {
        const long L = (long)i * G + c; if (L >= nwg) return false;
        int wgid = (int)L; { const int q = nwg / NXCD, r = nwg % NXCD, xcd = wgid % NXCD, off = wgid / NXCD; wgid = (xcd < r ? xcd * (q + 1) : r * (q + 1) + (xcd - r) * q) + off; }
        const int nig = WGM * nN, gid = wgid / nig, fm = gid * WGM, gsz = (nM - fm) < WGM ? (nM - fm) : WGM;
        u.pm = fm + ((wgid % nig) % gsz); u.pn = (wgid % nig) / gsz; return true;
    }
    __device__ __forceinline__ void a_ready(const Unit&) const {}
    __device__ __forceinline__ void done(const Unit&) const {}
};

__device__ __forceinline__ unsigned cvt_pk_bf16(float lo, float hi) { unsigned r; asm volatile("v_cvt_pk_bf16_f32 %0, %1, %2" : "=v"(r) : "v"(lo), "v"(hi)); return r; }
typedef float f32x2 __attribute__((ext_vector_type(2)));
__device__ __forceinline__ f32x2 gelu_pk(f32x2 v) {
    const f32x2 av = __builtin_elementwise_abs(v), d = av * 0.2316418882f + 1.0f;
    f32x2 t; t.x = __builtin_amdgcn_rcpf(d.x); t.y = __builtin_amdgcn_rcpf(d.y);
    f32x2 q = t * 0.5307027145f + (-0.7265760135f); q = q * t + 0.7107068705f; q = q * t + (-0.142248368f); q = q * t + 0.127414796f; q = q * t;
    const f32x2 s = (v * v) * (-0.72134752044f);
    f32x2 e; e.x = __builtin_amdgcn_exp2f(s.x); e.y = __builtin_amdgcn_exp2f(s.y);
    const f32x2 m = v * (q * e), r = v - m;
    f32x2 o; o.x = v.x < 0.f ? m.x : r.x; o.y = v.y < 0.f ? m.y : r.y; return o;
}

template <int ACT  > struct EpiBf16 {
    static constexpr bool PERM = true, AFTER_DRAIN = false; static_assert(ACT == 0 || ACT == 1, "EpiBf16: ACT is 0 (none) or 1 (gelu_pk)");
    bf16_t* O; int ldc; const float* bias; int split_cols; size_t split_stride; float scale0;
    __device__ __forceinline__ void operator()(const f32x4 (&acc)[2][2][4][2], const Unit& u, int wr, int wc, int fr, int fq) const {
        const int row0 = u.pm * BM + wr * 64 + fr; int colt = u.pn * BM; bf16_t* base = O;
        float sc = 1.f; if (split_cols) { const int t = colt / split_cols; base += (size_t)t * split_stride; colt -= t * split_cols; if (t == 0) sc = scale0; }
        const int col0 = colt + wc * 32 + 8 * fq, bcol0 = u.pn * BM + wc * 32 + 8 * fq;
        f32x4 bv[2][2];
#pragma unroll
        for (int bj = 0; bj < 2; ++bj)
#pragma unroll
            for (int n = 0; n < 2; ++n) bv[bj][n] = bias ? *(const f32x4*)(bias + bcol0 + bj * HALF + 4 * n) : (f32x4){0.f, 0.f, 0.f, 0.f};
#pragma unroll
        for (int ai = 0; ai < 2; ++ai)
#pragma unroll
            for (int m = 0; m < 4; ++m) { bf16_t* rowp = base + (size_t)(row0 + ai * HALF + m * 16) * ldc + col0;
#pragma unroll
                for (int bj = 0; bj < 2; ++bj) { f32x4 v0 = acc[ai][bj][m][0] + bv[bj][0], v1 = acc[ai][bj][m][1] + bv[bj][1];
                    if (ACT == 1) { f32x2 a = gelu_pk((f32x2){v0[0], v0[1]}), b = gelu_pk((f32x2){v0[2], v0[3]}), c = gelu_pk((f32x2){v1[0], v1[1]}), d = gelu_pk((f32x2){v1[2], v1[3]});
                        v0 = (f32x4){a.x, a.y, b.x, b.y}; v1 = (f32x4){c.x, c.y, d.x, d.y}; }
                    v0 = v0 * sc; v1 = v1 * sc; u32x4 w; w.x = cvt_pk_bf16(v0[0], v0[1]); w.y = cvt_pk_bf16(v0[2], v0[3]); w.z = cvt_pk_bf16(v1[0], v1[1]); w.w = cvt_pk_bf16(v1[2], v1[3]);
                    *(u32x4*)(rowp + bj * HALF) = w; } }
    }
};
struct EpiResid {
    static constexpr bool PERM = false, AFTER_DRAIN = false;
    const float* base; float* out; int ldc; float alpha;
    __device__ __forceinline__ void operator()(const f32x4 (&acc)[2][2][4][2], const Unit& u, int wr, int wc, int fr, int fq) const {
        const int row0 = u.pm * BM + wr * 64 + fr, col0 = u.pn * BM + wc * 32 + 4 * fq;
#pragma unroll
        for (int ai = 0; ai < 2; ++ai)
#pragma unroll
            for (int m = 0; m < 4; ++m) { const size_t off = (size_t)(row0 + ai * HALF + m * 16) * ldc + col0;
#pragma unroll
                for (int bj = 0; bj < 2; ++bj)
#pragma unroll
                    for (int n = 0; n < 2; ++n) { const f32x4 bs = *(const f32x4*)(base + off + bj * HALF + n * 16); *(f32x4*)(out + off + bj * HALF + n * 16) = bs * alpha + acc[ai][bj][m][n]; } }
    }
};
struct EpiSwiGLU {
    static constexpr bool PERM = true, AFTER_DRAIN = false;
    bf16_t* H; int ldh;
    __device__ __forceinline__ void operator()(const f32x4 (&acc)[2][2][4][2], const Unit& u, int wr, int wc, int fr, int fq) const {
        const int row0 = u.pm * BM + wr * 64 + fr, col0 = u.pn * HALF + wc * 32 + 8 * fq;
#pragma unroll
        for (int ai = 0; ai < 2; ++ai)
#pragma unroll
            for (int m = 0; m < 4; ++m) { bf16_t* rowp = H + (size_t)(row0 + ai * HALF + m * 16) * ldh + col0;
                float hv[8];
#pragma unroll
                for (int n = 0; n < 2; ++n)
#pragma unroll
                    for (int i = 0; i < 4; ++i) { const float a = acc[ai][0][m][n][i], b = acc[ai][1][m][n][i];
                        hv[4 * n + i] = a * __builtin_amdgcn_rcpf(1.0f + __builtin_amdgcn_exp2f(-1.4426950408889634f * a)) * b; }
                u32x4 w; w.x = cvt_pk_bf16(hv[0], hv[1]); w.y = cvt_pk_bf16(hv[2], hv[3]); w.z = cvt_pk_bf16(hv[4], hv[5]); w.w = cvt_pk_bf16(hv[6], hv[7]);
                *(u32x4*)rowp = w; }
    }
};
template <class Epi, class Sched, bool ALIGN_EPI = false, bool SP2 = false>
__device__ __forceinline__ void gemm_phase(PG8_LAS unsigned char* lds, const Gemm g, const Sched& S, const Epi& E) {
    const int tid = threadIdx.x, wid = __builtin_amdgcn_readfirstlane(tid >> 6), lane = tid & 63, wr = wid >> 2, wc = wid & 3, fr = lane & 15, fq = lane >> 4;
    const int K = g.K, nt = K / BK;
    unsigned voffA[2], voffB[2];
#pragma unroll
    for (int i = 0; i < 2; ++i) { int R, C; stage_rc(tid * 16 + i * 8192, R, C); const int Rb = Epi::PERM ? ((R & ~31) + perm32(R & 31)) : R;
        voffA[i] = (unsigned)(R * K + C) * 2u; voffB[i] = (unsigned)(Rb * K + C) * 2u; }
    const size_t kstep = (size_t)(BK * 2);
    const size_t hstep = (size_t)HALF * K * 2;
    const size_t tstep = 2 * hstep;
    const unsigned ldsw = (unsigned)wid * 1024u;
    const int aoff = lds_byte(wr * 64 + fr, fq * 8), boff = lds_byte(wc * 32 + fr, fq * 8);
#define PG8_SA(b, h) (((b) * 2 + (h)) * HTB)
#define PG8_SB(b, h) ((4 + (b) * 2 + (h)) * HTB)
#define PG8_STAGE(bufoff, gbase, voff) do { _Pragma("unroll") for (int _i = 0; _i < 2; ++_i) \
        __builtin_amdgcn_global_load_lds((const unsigned*)((const char*)(gbase) + (voff)[_i]), (PG8_LAS unsigned*)(lds + (bufoff) + ldsw + _i * 8192), 16, 0, 0); } while (0)
#define PG8_LDA(dst, b, h) do { _Pragma("unroll") for (int m = 0; m < 4; ++m) _Pragma("unroll") for (int k = 0; k < 2; ++k) dst[m][k] = *(const PG8_LAS bf16x8*)(lds + PG8_SA(b, h) + aoff + m * 2048 + k * 1024); } while (0)
#define PG8_LDB(dst, b, h) do { _Pragma("unroll") for (int n = 0; n < 2; ++n) _Pragma("unroll") for (int k = 0; k < 2; ++k) dst[n][k] = *(const PG8_LAS bf16x8*)(lds + PG8_SB(b, h) + boff + n * 2048 + k * 1024); } while (0)
#define PG8_MMA(ai, bj, At, Bt) do { __builtin_amdgcn_s_setprio(1); _Pragma("unroll") for (int m = 0; m < 4; ++m) _Pragma("unroll") for (int n = 0; n < 2; ++n) _Pragma("unroll") for (int k = 0; k < 2; ++k) \
        acc[ai][bj][m][n] = __builtin_amdgcn_mfma_f32_16x16x32_bf16(Bt[n][k], At[m][k], acc[ai][bj][m][n], 0, 0, 0); __builtin_amdgcn_s_setprio(0); } while (0)
#define PG8_WAIT_V(n) asm volatile("s_waitcnt vmcnt(" #n ")" ::: "memory")
#define PG8_WAIT_L(n) asm volatile("s_waitcnt lgkmcnt(" #n ")" ::: "memory")
#define PG8_BAR __builtin_amdgcn_s_barrier()
#define PG8_SCHED __builtin_amdgcn_sched_barrier(0)
    Unit cur, nxt; int ui = 0;
    if (!S.next(0, cur)) return;
    f32x4 acc[2][2][4][2];
#pragma unroll
    for (int a = 0; a < 2; ++a)
#pragma unroll
        for (int b = 0; b < 2; ++b)
#pragma unroll
            for (int m = 0; m < 4; ++m)
#pragma unroll
                for (int n = 0; n < 2; ++n) acc[a][b][m][n] = (f32x4){0.f, 0.f, 0.f, 0.f};
    bf16x8 At[4][2], B0[2][2], B1[2][2];
    const char* cA = (const char*)g.A + (size_t)cur.pm * tstep; const char* cB = (const char*)g.Bt + (size_t)cur.pn * tstep;
    S.a_ready(cur);
    if constexpr (SP2) {
        PG8_STAGE(PG8_SB(0, 0), cB, voffB); PG8_STAGE(PG8_SB(0, 1), cB + hstep, voffB); PG8_STAGE(PG8_SA(0, 0), cA, voffA); PG8_STAGE(PG8_SA(0, 1), cA + hstep, voffA);
        if (wr == 1) PG8_BAR;
        PG8_WAIT_V(2); PG8_BAR;
        PG8_STAGE(PG8_SB(1, 0), cB + kstep, voffB); PG8_STAGE(PG8_SA(1, 0), cA + kstep, voffA); PG8_STAGE(PG8_SB(1, 1), cB + hstep + kstep, voffB);
        PG8_WAIT_V(6); PG8_BAR;
    } else {
        PG8_STAGE(PG8_SB(0, 0), cB, voffB); PG8_STAGE(PG8_SA(0, 0), cA, voffA); PG8_STAGE(PG8_SB(0, 1), cB + hstep, voffB); PG8_STAGE(PG8_SA(0, 1), cA + hstep, voffA);
        if (wr == 1) PG8_BAR;
        PG8_WAIT_V(4); PG8_BAR;
        PG8_STAGE(PG8_SB(1, 0), cB + kstep, voffB); PG8_STAGE(PG8_SA(1, 0), cA + kstep, voffA); PG8_STAGE(PG8_SB(1, 1), cB + hstep + kstep, voffB);
        PG8_WAIT_V(6); PG8_BAR;
    }
    for (;;) {
        const bool has_next = S.next(ui + 1, nxt);
        const char* nA = has_next ? (const char*)g.A + (size_t)nxt.pm * tstep : cA; const char* nB = has_next ? (const char*)g.Bt + (size_t)nxt.pn * tstep : cB;
        for (int t = 0; t < nt; t += 2) {
            const bool last = (t == nt - 2);
            const char* a1 = cA + (size_t)(t + 1) * kstep;
            const char* a2 = last ? nA : cA + (size_t)(t + 2) * kstep; const char* b2 = last ? nB : cB + (size_t)(t + 2) * kstep;
            const char* a3 = a2 + kstep; const char* b3 = b2 + kstep;
            if (last && has_next) S.a_ready(nxt);
            if constexpr (SP2) {
            PG8_LDB(B0, 0, 0); PG8_LDB(B1, 0, 1); PG8_SCHED; PG8_LDA(At, 0, 0); PG8_STAGE(PG8_SA(1, 1), a1 + hstep, voffA);
            PG8_WAIT_V(8); PG8_WAIT_L(0); PG8_BAR; PG8_MMA(0, 0, At, B0); PG8_MMA(0, 1, At, B1); PG8_BAR; PG8_SCHED;
            PG8_LDA(At, 0, 1); PG8_STAGE(PG8_SB(0, 0), b2, voffB); PG8_STAGE(PG8_SB(0, 1), b2 + hstep, voffB); PG8_STAGE(PG8_SA(0, 0), a2, voffA);
            PG8_WAIT_V(8); PG8_WAIT_L(0); PG8_BAR; PG8_MMA(1, 0, At, B0); PG8_MMA(1, 1, At, B1); PG8_BAR; PG8_SCHED;
            PG8_LDB(B0, 1, 0); PG8_LDB(B1, 1, 1); PG8_SCHED; PG8_LDA(At, 1, 0); PG8_STAGE(PG8_SA(0, 1), a2 + hstep, voffA);
            PG8_WAIT_V(8); PG8_WAIT_L(0); PG8_BAR; PG8_MMA(0, 0, At, B0); PG8_MMA(0, 1, At, B1); PG8_BAR; PG8_SCHED;
            PG8_LDA(At, 1, 1); PG8_STAGE(PG8_SB(1, 0), b3, voffB); PG8_STAGE(PG8_SB(1, 1), b3 + hstep, voffB); PG8_STAGE(PG8_SA(1, 0), a3, voffA);
            PG8_WAIT_V(8); PG8_WAIT_L(0); PG8_BAR; PG8_MMA(1, 0, At, B0); PG8_MMA(1, 1, At, B1); PG8_BAR; PG8_SCHED;
            } else {
            PG8_LDB(B0, 0, 0); PG8_SCHED; PG8_LDA(At, 0, 0); PG8_STAGE(PG8_SA(1, 1), a1 + hstep, voffA);
            PG8_WAIT_L(8); PG8_BAR; PG8_WAIT_L(0); PG8_MMA(0, 0, At, B0); PG8_BAR; PG8_SCHED;
            PG8_LDB(B1, 0, 1); PG8_STAGE(PG8_SB(0, 0), b2, voffB);
            PG8_BAR; PG8_WAIT_L(0); PG8_MMA(0, 1, At, B1); PG8_BAR;
            PG8_LDA(At, 0, 1); PG8_STAGE(PG8_SA(0, 0), a2, voffA);
            PG8_BAR; PG8_WAIT_L(0); PG8_MMA(1, 0, At, B0); PG8_BAR; PG8_SCHED;
            PG8_STAGE(PG8_SB(0, 1), b2 + hstep, voffB);
            PG8_WAIT_V(6); PG8_BAR; PG8_MMA(1, 1, At, B1); PG8_BAR;
            PG8_LDB(B0, 1, 0); PG8_SCHED; PG8_LDA(At, 1, 0); PG8_STAGE(PG8_SA(0, 1), a2 + hstep, voffA);
            PG8_WAIT_L(8); PG8_BAR; PG8_WAIT_L(0); PG8_MMA(0, 0, At, B0); PG8_BAR; PG8_SCHED;
            PG8_LDB(B1, 1, 1); PG8_STAGE(PG8_SB(1, 0), b3, voffB);
            PG8_BAR; PG8_WAIT_L(0); PG8_MMA(0, 1, At, B1); PG8_BAR;
            PG8_LDA(At, 1, 1); PG8_STAGE(PG8_SA(1, 0), a3, voffA);
            PG8_BAR; PG8_WAIT_L(0); PG8_MMA(1, 0, At, B0); PG8_BAR; PG8_SCHED;
            PG8_STAGE(PG8_SB(1, 1), b3 + hstep, voffB);
            PG8_WAIT_V(6); PG8_BAR; PG8_MMA(1, 1, At, B1); PG8_BAR;
            }
        }
        if constexpr (ALIGN_EPI) { if (wr == 0) PG8_BAR; }
        if constexpr (!Epi::AFTER_DRAIN) { E(acc, cur, wr, wc, fr, fq); S.done(cur); }
        if (!has_next) break;
#pragma unroll
        for (int a = 0; a < 2; ++a)
#pragma unroll
            for (int b = 0; b < 2; ++b)
#pragma unroll
                for (int m = 0; m < 4; ++m)
#pragma unroll
                    for (int n = 0; n < 2; ++n) acc[a][b][m][n] = (f32x4){0.f, 0.f, 0.f, 0.f};
        cur = nxt; cA = nA; cB = nB; ++ui;
        if constexpr (ALIGN_EPI) { if (wr == 1) PG8_BAR; }
    }
    PG8_WAIT_V(0);
    if constexpr (!ALIGN_EPI) { if (wr == 0) PG8_BAR; }
    PG8_BAR;
    if constexpr (Epi::AFTER_DRAIN) { E.fused(acc, cur, wr, wc, fr, fq, lds, wid, lane); S.done(cur); }
#undef PG8_SA
#undef PG8_SB
#undef PG8_STAGE
#undef PG8_LDA
#undef PG8_LDB
#undef PG8_MMA
#undef PG8_WAIT_V
#undef PG8_WAIT_L
#undef PG8_BAR
#undef PG8_SCHED
}
}
__device__ __forceinline__ void p0_transpose_item(const float* W, int ldw, int K, int nblk, bf16_t* WT, int mode, LAS float* scr, int item, int lane) {
    const int kb = item / nblk, nb = item % nblk, k0 = 64 * kb, n0 = 32 * nb;
#pragma unroll 8
    for (int i = 0; i < 32; ++i) { const int kk = 2 * i + (lane >> 5); scr[kk * 33 + (lane & 31)] = W[(size_t)(k0 + kk) * ldw + n0 + (lane & 31)]; }
    asm volatile("s_waitcnt lgkmcnt(0)" ::: "memory");
    int r0 = n0;
    if (mode == 1) { const int half = n0 >= DFF ? 1 : 0; const int j = n0 - half * DFF; r0 = 256 * (j >> 7) + 128 * half + (j & 127); }
    const int c = lane & 7;
#pragma unroll
    for (int j = 0; j < 4; ++j) { const int n = (lane >> 3) + 8 * j; const LAS float* s = scr + (8 * c) * 33 + n;
        u32x4 o; o.x = cvtpk(s[0 * 33], s[1 * 33]); o.y = cvtpk(s[2 * 33], s[3 * 33]); o.z = cvtpk(s[4 * 33], s[5 * 33]); o.w = cvtpk(s[6 * 33], s[7 * 33]);
        *(u32x4*)(WT + (size_t)(r0 + n) * K + k0 + 8 * c) = o; }
    asm volatile("s_waitcnt lgkmcnt(0)" ::: "memory");
}

struct P { const float *x, *ev_w_in, *ev_w_out, *od_w_in, *od_w_out, *w13, *w2; unsigned char* ws; };

__device__ __forceinline__ void phase_prologue(const P& p, LAS unsigned char* lds, int gw, int NGW, int wave, int lane, int tid) {
    LAS float* scr = (LAS float*)(lds + wave * 8704);
    LAS float* fbw = (LAS float*)(lds + 69632);
    for (int i = tid; i < 1024 * 8; i += 512) fbw[i] = p.ev_w_in[(size_t)(i >> 3) * EVEN_IN + EVEN_N + (i & 7)];
    constexpr int I0 = 16 * (EVEN_N / 32), I1 = 16 * 32, I2 = 16 * (ODD_IN / 32), I3 = 16 * 32, I4 = 16 * (DFF2 / 32), I5 = (DFF / 64) * 32;
    constexpr int NITEMS = I0 + I1 + I2 + I3 + 2 * I4 + 2 * I5;
    for (int it = gw; it < NITEMS; it += NGW) {
        int r = it;
        if (r < I0) { p0_transpose_item(p.ev_w_in, EVEN_IN, DM, EVEN_N / 32, (bf16_t*)(p.ws + WS_WIN0), 0, scr, r, lane); continue; } r -= I0;
        if (r < I1) { p0_transpose_item(p.ev_w_out, DM, DM, 32, (bf16_t*)(p.ws + WS_WOUT0), 0, scr, r, lane); continue; } r -= I1;
        if (r < I2) { p0_transpose_item(p.od_w_in, ODD_IN, DM, ODD_IN / 32, (bf16_t*)(p.ws + WS_WIN1), 0, scr, r, lane); continue; } r -= I2;
        if (r < I3) { p0_transpose_item(p.od_w_out, DM, DM, 32, (bf16_t*)(p.ws + WS_WOUT1), 0, scr, r, lane); continue; } r -= I3;
        if (r < 2 * I4) { const int l = r / I4; p0_transpose_item(p.w13 + (size_t)l * DM * DFF2, DFF2, DM, DFF2 / 32, (bf16_t*)(p.ws + WS_W13 + l * W13_BYTES), 1, scr, r % I4, lane); continue; } r -= 2 * I4;
        { const int l = r / I5; p0_transpose_item(p.w2 + (size_t)l * DFF * DM, DM, DFF, 32, (bf16_t*)(p.ws + WS_W2 + l * W2_BYTES), 0, scr, r % I5, lane); }
    }
        __syncthreads();
    bf16_t* XB = (bf16_t*)(p.ws + WS_XB); float* FB = (float*)(p.ws + WS_FB);
    for (int m = gw; m < MROWS; m += NGW) {
        const f32x4* xr = (const f32x4*)(p.x + (size_t)m * DM) + lane;
        f32x4 v[4];
#pragma unroll
        for (int j = 0; j < 4; ++j) v[j] = xr[64 * j];
        unsigned long long* o8 = (unsigned long long*)(XB + (size_t)m * DM) + lane;
        float fa[8];
#pragma unroll
        for (int h = 0; h < 8; ++h) fa[h] = 0.f;
#pragma unroll
        for (int j = 0; j < 4; ++j) {
            o8[64 * j] = (unsigned long long)cvtpk(v[j].x, v[j].y) | ((unsigned long long)cvtpk(v[j].z, v[j].w) << 32);
#pragma unroll
            for (int c = 0; c < 4; ++c) { const int k = 4 * (lane + 64 * j) + c; const f32x4 w0 = *(const LAS f32x4*)(fbw + 8 * k), w1 = *(const LAS f32x4*)(fbw + 8 * k + 4); const float xv = v[j][c];
                fa[0] += xv * w0.x; fa[1] += xv * w0.y; fa[2] += xv * w0.z; fa[3] += xv * w0.w; fa[4] += xv * w1.x; fa[5] += xv * w1.y; fa[6] += xv * w1.z; fa[7] += xv * w1.w; }
        }
#pragma unroll
        for (int h = 0; h < 8; ++h) fa[h] = wave_sum(fa[h]);
        if (lane == 0) { *(f32x4*)(FB + (size_t)m * 8) = (f32x4){fa[0], fa[1], fa[2], fa[3]}; *(f32x4*)(FB + (size_t)m * 8 + 4) = (f32x4){fa[4], fa[5], fa[6], fa[7]}; }
    }
}

__device__ __forceinline__ void phase_ln(const float* y, float* xo, bf16_t* xb, const float* g, const float* b, int gw, int NGW, int lane) {
    f32x4 gv[4], bv[4];
#pragma unroll
    for (int j = 0; j < 4; ++j) { gv[j] = ((const f32x4*)g)[lane + 64 * j]; bv[j] = ((const f32x4*)b)[lane + 64 * j]; }
    for (int m = gw; m < MROWS; m += NGW) {
        const f32x4* yr = (const f32x4*)(y + (size_t)m * DM) + lane;
        f32x4 v[4]; float s = 0.f;
#pragma unroll
        for (int j = 0; j < 4; ++j) { v[j] = yr[64 * j]; s += (v[j].x + v[j].y) + (v[j].z + v[j].w); }
        const float mean = wave_sum(s) * (1.f / DM); float s2 = 0.f;
#pragma unroll
        for (int j = 0; j < 4; ++j) { v[j] = v[j] - mean; s2 += (v[j].x * v[j].x + v[j].y * v[j].y) + (v[j].z * v[j].z + v[j].w * v[j].w); }
        const float rstd = __builtin_amdgcn_rsqf(wave_sum(s2) * (1.f / DM) + LN_EPS);
        f32x4* xr = (f32x4*)(xo + (size_t)m * DM) + lane;
        unsigned long long* o8 = xb ? (unsigned long long*)(xb + (size_t)m * DM) + lane : nullptr;
#pragma unroll
        for (int j = 0; j < 4; ++j) { const f32x4 o = v[j] * rstd * gv[j] + bv[j]; xr[64 * j] = o;
            if (xb) o8[64 * j] = (unsigned long long)cvtpk(o.x, o.y) | ((unsigned long long)cvtpk(o.z, o.w) << 32); }
    }
}
namespace att {
constexpr int KP = 144, VP = 192, KBUF = 64 * KP, VBUF = 64 * VP;
constexpr int OFF_K = 0, OFF_V = 2 * KBUF, OFF_C = OFF_V + 2 * VBUF, OFF_SCAN = OFF_C + 2048 * 4;
static_assert(OFF_SCAN + 64 <= LDS_MISC, "attention LDS map");

__device__ __forceinline__ void qkt(f32x16& p0, f32x16& p1, const LAS char* Kb, const bf16x8 (&qr)[4], int r, int hi) {
    p0 = f32x16{}; p1 = f32x16{};
#pragma unroll
    for (int ks = 0; ks < 4; ++ks) {
        const bf16x8 k0 = *(const LAS bf16x8*)(Kb + r * KP + (16 * ks + 8 * hi) * 2);
        const bf16x8 k1 = *(const LAS bf16x8*)(Kb + (32 + r) * KP + (16 * ks + 8 * hi) * 2);
        p0 = MFMA32(k0, qr[ks], p0); p1 = MFMA32(k1, qr[ks], p1);
    }
}
__device__ __forceinline__ void pv(f32x16& o0, f32x16& o1, const LAS char* Vb, const bf16x8 (&pb)[4], int lane, int hi) {
    const LAS char* vb = Vb + (4 * hi + ((lane & 15) >> 2)) * VP + (16 * ((lane >> 4) & 1) + 4 * (lane & 3)) * 2;
#pragma unroll
    for (int st = 0; st < 4; ++st) {
#pragma unroll
        for (int dt = 0; dt < 2; ++dt) {
            const s16x4 lo = vtr(vb + (16 * st) * VP + 64 * dt), hh = vtr(vb + (16 * st + 8) * VP + 64 * dt);
            const bf16x8 a = (bf16x8){lo[0], lo[1], lo[2], lo[3], hh[0], hh[1], hh[2], hh[3]};
            if (dt == 0) o0 = MFMA32(a, pb[st], o0); else o1 = MFMA32(a, pb[st], o1);
        }
    }
}
__device__ __forceinline__ void store_o(bf16_t* orow, const f32x16& o0, const f32x16& o1, float sc, int hi) {
#pragma unroll
    for (int dt = 0; dt < 2; ++dt)
#pragma unroll
        for (int g = 0; g < 4; ++g) { const f32x16& o = dt ? o1 : o0; u32x2 w; w.x = cvtpk(o[4 * g] * sc, o[4 * g + 1] * sc); w.y = cvtpk(o[4 * g + 2] * sc, o[4 * g + 3] * sc);
            *(u32x2*)(orow + 32 * dt + 8 * g + 4 * hi) = w; }
}

template <int MODE>
__device__ __forceinline__ void attn_unit(LAS char* lds, const bf16_t* Qg, const bf16_t* Kg, const bf16_t* Vg, int ldp, const float* fbcol  , float fbias, bf16_t* Og  , int qb) {
    const int tid = threadIdx.x, lane = tid & 63, r = lane & 31, hi = lane >> 5, w = __builtin_amdgcn_readfirstlane(tid >> 6);
    const int q0 = qb * 256, q1 = q0 + 256, NT = q1 / 64;
    LAS float* C = (LAS float*)(lds + OFF_C);
    if (MODE == 0) {
        LAS float* SC = (LAS float*)(lds + OFF_SCAN);
        float v[4]; float loc = 0.f;
#pragma unroll
        for (int e = 0; e < 4; ++e) { const int s = 4 * tid + e; float ls = 0.f;
            if (s < q1) { const float xx = fbcol[(size_t)s * 8] + fbias; ls = fminf(xx, 0.f) - log1pf(expf(-fabsf(xx))); }
            loc += ls; v[e] = loc; }
        float inc = loc;
#pragma unroll
        for (int o = 1; o < 64; o <<= 1) { const float t = __shfl_up(inc, o); if (lane >= o) inc += t; }
        if (lane == 63) SC[w] = inc;
        __syncthreads();
        float pre = inc - loc;
#pragma unroll
        for (int ww = 0; ww < 8; ++ww) if (ww < w) pre += SC[ww];
#pragma unroll
        for (int e = 0; e < 4; ++e) C[4 * tid + e] = (pre + v[e]) * LOG2E;
    }
    const int trow = q0 + 32 * w + r;
    bf16x8 qr[4];
#pragma unroll
    for (int ks = 0; ks < 4; ++ks) qr[ks] = *(const bf16x8*)(Qg + (size_t)trow * ldp + 16 * ks + 8 * hi);
    const int lr = tid >> 3, lc = tid & 7;
    const bf16_t* kptr = Kg + (size_t)lr * ldp + 8 * lc; const bf16_t* vptr = Vg + (size_t)lr * ldp + 8 * lc;
    LAS char* kst = lds + OFF_K + lr * KP + lc * 16; LAS char* vst = lds + OFF_V + lr * VP + lc * 16;
    const int jfirst = (MODE == 0) ? 0 : NT - 1, jstep = (MODE == 0) ? 1 : -1;
    u32x4 kreg = *(const u32x4*)(kptr + (size_t)(64 * jfirst) * ldp), vreg = *(const u32x4*)(vptr + (size_t)(64 * jfirst) * ldp);
    *(LAS u32x4*)kst = kreg; *(LAS u32x4*)vst = vreg;
    __syncthreads();
    const float ct = (MODE == 0) ? C[trow] : 0.f;
    float m = -1e30f, l = 0.f, R = 0.f;
    f32x16 o0 = f32x16{}, o1 = f32x16{};
    const int tmax_w = q0 + 32 * w + 31, tmin_w = q0 + 32 * w;
    for (int it = 0; it < NT; ++it) {
        const int j = jfirst + jstep * it, buf = it & 1;
        const bool more = it + 1 < NT;
        if (more) { const int jn = j + jstep; kreg = *(const u32x4*)(kptr + (size_t)(64 * jn) * ldp); vreg = *(const u32x4*)(vptr + (size_t)(64 * jn) * ldp); }
        if (64 * j <= tmax_w) {
            const LAS char* Kb = lds + OFF_K + buf * KBUF; const LAS char* Vb = lds + OFF_V + buf * VBUF;
            f32x16 p0, p1; qkt(p0, p1, Kb, qr, r, hi);
            const int sb = 64 * j + 4 * hi;
            const bool diag = (64 * j + 63 > tmin_w - (MODE == 1 ? 1 : 0)) || (MODE == 1 && 64 * j + 63 >= tmin_w);
            bf16x8 pb[4];
            if (MODE == 0) {
                float mx = -1e30f;
#pragma unroll
                for (int i = 0; i < 16; ++i) { const int s = sb + (i & 3) + 8 * (i >> 2);
                    float x0 = p0[i] * QK_C2 + (ct - C[s]), x1 = p1[i] * QK_C2 + (ct - C[s + 32]);
                    if (diag) { if (s > trow) x0 = -INFINITY; if (s + 32 > trow) x1 = -INFINITY; }
                    p0[i] = x0; p1[i] = x1; mx = fmaxf(mx, fmaxf(x0, x1)); }
                mx = fmaxf(mx, __shfl_xor(mx, 32));
                const float mn = fmaxf(m, mx), al = ex2(m - mn); m = mn;
                float sum = 0.f;
#pragma unroll
                for (int i = 0; i < 16; ++i) { p0[i] = ex2(p0[i] - mn); p1[i] = ex2(p1[i] - mn); sum += p0[i] + p1[i]; }
                l = l * al + sum;
#pragma unroll
                for (int i = 0; i < 16; ++i) { o0[i] *= al; o1[i] *= al; }
            } else {
                f32x16 L0, L1;
#pragma unroll
                for (int i = 0; i < 16; ++i) { const int s = sb + (i & 3) + 8 * (i >> 2);
                    const float z0 = p0[i] * QK_C2, z1 = p1[i] * QK_C2;
                    float a0 = -(fmaxf(z0, 0.f) + lg2(1.f + ex2(-fabsf(z0)))), a1 = -(fmaxf(z1, 0.f) + lg2(1.f + ex2(-fabsf(z1))));
                    if (diag) { if (s >= trow) a0 = 0.f; if (s + 32 >= trow) a1 = 0.f; }
                    p0[i] = z0; p1[i] = z1; L0[i] = a0; L1[i] = a1; }
                float gs[8], pg[8];
#pragma unroll
                for (int g = 0; g < 4; ++g) { gs[g] = (L0[4 * g] + L0[4 * g + 1]) + (L0[4 * g + 2] + L0[4 * g + 3]); gs[4 + g] = (L1[4 * g] + L1[4 * g + 1]) + (L1[4 * g + 2] + L1[4 * g + 3]); }
#pragma unroll
                for (int g = 0; g < 8; ++g) pg[g] = __shfl_xor(gs[g], 32);
                float T = R;
#pragma unroll
                for (int G = 7; G >= 0; --G) {
                    const float off = T + (hi == 0 ? pg[G] : 0.f);
                    f32x16& LL = (G >= 4) ? L1 : L0; f32x16& PP = (G >= 4) ? p1 : p0; const int b4 = 4 * (G & 3);
                    const float a3 = off + LL[b4 + 3], a2 = a3 + LL[b4 + 2], a1 = a2 + LL[b4 + 1], a0 = a1 + LL[b4];
                    PP[b4 + 3] = ex2(PP[b4 + 3] + a3); PP[b4 + 2] = ex2(PP[b4 + 2] + a2); PP[b4 + 1] = ex2(PP[b4 + 1] + a1); PP[b4] = ex2(PP[b4] + a0);
                    T += gs[G] + pg[G];
                }
                R = T;
                if (diag) {
#pragma unroll
                    for (int i = 0; i < 16; ++i) { const int s = sb + (i & 3) + 8 * (i >> 2); if (s >= trow) p0[i] = 0.f; if (s + 32 >= trow) p1[i] = 0.f; }
                }
            }
            pb[0] = pack8(p0, 0); pb[1] = pack8(p0, 8); pb[2] = pack8(p1, 0); pb[3] = pack8(p1, 8);
            pv(o0, o1, Vb, pb, lane, hi);
        }
        if (more) { *(LAS u32x4*)(kst + (buf ^ 1) * KBUF) = kreg; *(LAS u32x4*)(vst + (buf ^ 1) * VBUF) = vreg; }
        __syncthreads();
    }
    float sc = 1.f;
    if (MODE == 0) { l += __shfl_xor(l, 32); sc = 1.f / l; }
    store_o(Og + (size_t)trow * DM, o0, o1, sc, hi);
}
}
namespace hg {
constexpr int P272 = 272, PKH = 144, PV = 320;
constexpr int H_QP = 0, H_QI = 17408, H_KT = 34816, H_KH = 52224, H_V = 70656, H_ST = 91136, H_BL = 125952, H_PART = 126464, H_RMS = 128512, H_END = 129536;
static_assert(H_END <= LDS_MISC, "hgrn LDS map");
constexpr int LDP = EVEN_N;

__device__ __forceinline__ void hgrn_unit(LAS char* lds, const bf16_t* proj, const float* lb3  , const float* norm_g, bf16_t* ycat, int b, int h) {
    const int tid = threadIdx.x, lane = tid & 63, r = lane & 31, hi = lane >> 5, w = __builtin_amdgcn_readfirstlane(tid >> 6);
    const int k = tid & 127, tq = tid >> 7;
    const int th = w >> 2, vs = w & 3;
    float lbk;
    { const float l0 = lb3[128 * h + k], l1 = lb3[512 + 128 * h + k], l2 = lb3[1024 + 128 * h + k]; const float mx = fmaxf(l0, fmaxf(l1, l2));
      const float e0 = expf(l0 - mx), e1 = expf(l1 - mx), e2 = expf(l2 - mx); lbk = e0 / (e0 + e1 + e2); }
    const bf16_t* base = proj + (size_t)(b * SEQ) * LDP + 128 * h;
    for (int i = tid; i < (128 * P272) / 16; i += 512) *(LAS u32x4*)(lds + H_ST + 16 * i) = (u32x4){0u, 0u, 0u, 0u};
    f32x16 s0 = f32x16{}, s1 = f32x16{};
    const int kt0 = 2 * (w >> 2), kt1 = kt0 + 1;
    LAS float* PART = (LAS float*)(lds + H_PART); LAS float* BL = (LAS float*)(lds + H_BL); LAS float* RMS = (LAS float*)(lds + H_RMS);
    float ngv[4][4];
#pragma unroll
    for (int g = 0; g < 4; ++g)
#pragma unroll
        for (int e = 0; e < 4; ++e) ngv[g][e] = norm_g[32 * vs + 8 * g + 4 * hi + e];
    const int vr0 = tid >> 4, vc = tid & 15;
    unsigned short qz[32]; u32x4 vreg[2];
#define HG_LOAD(c) do { const bf16_t* pb_ = base + (size_t)(64 * (c) + 16 * tq) * LDP + k; \
        _Pragma("unroll") for (int i = 0; i < 16; ++i) { qz[i] = pb_[(size_t)i * LDP]; qz[16 + i] = pb_[(size_t)i * LDP + 512]; } \
        _Pragma("unroll") for (int i = 0; i < 2; ++i) vreg[i] = *(const u32x4*)(base + (size_t)(64 * (c) + vr0 + 32 * i) * LDP + 1024 + 8 * vc); } while (0)
    HG_LOAD(0);
    for (int c = 0; c < SEQ / 64; ++c) {
        float Lc[16], kk[16], qv[16];
        float run = 0.f;
#pragma unroll
        for (int i = 0; i < 16; ++i) { const float z = bf2f(qz[16 + i]); qv[i] = bf2f(qz[i]);
            const float sg = frcp(1.f + ex2(-LOG2E * z)); const float f = lbk + (1.f - lbk) * sg;
            run += lg2(f); Lc[i] = run; kk[i] = (1.f - lbk) * (1.f - sg); }
        PART[tq * 128 + k] = run;
#pragma unroll
        for (int i = 0; i < 2; ++i) *(LAS u32x4*)(lds + H_V + (vr0 + 32 * i) * PV + vc * 16) = vreg[i];
        __syncthreads();
        const float pa = PART[k], pbb = PART[128 + k], pc = PART[256 + k], pd = PART[384 + k];
        const float pre = (tq > 0 ? pa : 0.f) + (tq > 1 ? pbb : 0.f) + (tq > 2 ? pc : 0.f);
        const float bmid = pa + pbb, blast = bmid + pc + pd;
        const float Emid = ex2(bmid), Elm = ex2(blast - bmid);
        if (tq == 0) BL[k] = ex2(blast);
        unsigned khp[8];
#pragma unroll
        for (int i = 0; i < 16; i += 2) {
            float e1a = ex2(pre + Lc[i] - bmid), e1b = ex2(pre + Lc[i + 1] - bmid);
            float e3a = ex2(bmid - pre - Lc[i]), e3b = ex2(bmid - pre - Lc[i + 1]);
            const int t = 16 * tq + i;
            const float qpa = qv[i] * e1a, qpb = qv[i + 1] * e1b, kta = kk[i] * e3a, ktb = kk[i + 1] * e3b;
            *(LAS bf16_t*)(lds + H_QP + t * P272 + k * 2) = (bf16_t)cvtpk(qpa, 0.f); *(LAS bf16_t*)(lds + H_QP + (t + 1) * P272 + k * 2) = (bf16_t)cvtpk(qpb, 0.f);
            *(LAS bf16_t*)(lds + H_QI + t * P272 + k * 2) = (bf16_t)cvtpk(qpa * Emid, 0.f); *(LAS bf16_t*)(lds + H_QI + (t + 1) * P272 + k * 2) = (bf16_t)cvtpk(qpb * Emid, 0.f);
            *(LAS bf16_t*)(lds + H_KT + t * P272 + k * 2) = (bf16_t)cvtpk(kta, 0.f); *(LAS bf16_t*)(lds + H_KT + (t + 1) * P272 + k * 2) = (bf16_t)cvtpk(ktb, 0.f);
            khp[i >> 1] = cvtpk(kta * Elm, ktb * Elm);
        }
        *(LAS u32x4*)(lds + H_KH + k * PKH + tq * 32) = (u32x4){khp[0], khp[1], khp[2], khp[3]};
        *(LAS u32x4*)(lds + H_KH + k * PKH + tq * 32 + 16) = (u32x4){khp[4], khp[5], khp[6], khp[7]};
        __syncthreads();
        if (c + 1 < SEQ / 64) HG_LOAD(c + 1);
        bf16x8 pb0[2], pb1[2];
        {
            f32x16 acc = f32x16{};
#pragma unroll
            for (int ks = 0; ks < 8; ++ks) { const bf16x8 a = *(const LAS bf16x8*)(lds + H_KT + r * P272 + (16 * ks + 8 * hi) * 2), bq = *(const LAS bf16x8*)(lds + H_QP + (32 * th + r) * P272 + (16 * ks + 8 * hi) * 2); acc = MFMA32(a, bq, acc); }
            if (th == 0) {
#pragma unroll
                for (int i = 0; i < 16; ++i) if (crow(i, hi) > r) acc[i] = 0.f;
            }
            pb0[0] = pack8(acc, 0); pb0[1] = pack8(acc, 8);
        }
        if (th == 1) {
            f32x16 acc = f32x16{};
#pragma unroll
            for (int ks = 0; ks < 8; ++ks) { const bf16x8 a = *(const LAS bf16x8*)(lds + H_KT + (32 + r) * P272 + (16 * ks + 8 * hi) * 2), bq = *(const LAS bf16x8*)(lds + H_QP + (32 + r) * P272 + (16 * ks + 8 * hi) * 2); acc = MFMA32(a, bq, acc); }
#pragma unroll
            for (int i = 0; i < 16; ++i) if (crow(i, hi) > r) acc[i] = 0.f;
            pb1[0] = pack8(acc, 0); pb1[1] = pack8(acc, 8);
        } else { pb1[0] = bf16x8{}; pb1[1] = bf16x8{}; }
        f32x16 o = f32x16{};
#pragma unroll
        for (int ks = 0; ks < 8; ++ks) { const bf16x8 a = *(const LAS bf16x8*)(lds + H_ST + (32 * vs + r) * P272 + (16 * ks + 8 * hi) * 2), bq = *(const LAS bf16x8*)(lds + H_QI + (32 * th + r) * P272 + (16 * ks + 8 * hi) * 2); o = MFMA32(a, bq, o); }
        const LAS char* vb = lds + H_V + (4 * hi + ((lane & 15) >> 2)) * PV + (32 * vs + 16 * ((lane >> 4) & 1) + 4 * (lane & 3)) * 2;
#pragma unroll
        for (int st = 0; st < 2; ++st) { const s16x4 lo = vtr(vb + (16 * st) * PV), hh = vtr(vb + (16 * st + 8) * PV);
            o = MFMA32(((bf16x8){lo[0], lo[1], lo[2], lo[3], hh[0], hh[1], hh[2], hh[3]}), pb0[st], o); }
        if (th == 1) {
#pragma unroll
            for (int st = 0; st < 2; ++st) { const s16x4 lo = vtr(vb + (32 + 16 * st) * PV), hh = vtr(vb + (32 + 16 * st + 8) * PV);
                o = MFMA32(((bf16x8){lo[0], lo[1], lo[2], lo[3], hh[0], hh[1], hh[2], hh[3]}), pb1[st], o); }
        }
        { float ss = 0.f;
#pragma unroll
          for (int i = 0; i < 16; ++i) ss += o[i] * o[i];
          ss += __shfl_xor(ss, 32);
          if (hi == 0) RMS[vs * 64 + 32 * th + r] = ss; }
        __syncthreads();
        { const int tl = 32 * th + r; const float tot = (RMS[tl] + RMS[64 + tl]) + (RMS[128 + tl] + RMS[192 + tl]);
          const float rstd = __builtin_amdgcn_rsqf(tot * (1.f / 128.f) + LN_EPS);
          const size_t row = (size_t)(b * SEQ + 64 * c + tl);
#pragma unroll
          for (int g = 0; g < 4; ++g) { const int v0 = 32 * vs + 8 * g + 4 * hi;
              const u32x2 gg = *(const u32x2*)(base + (size_t)(64 * c + tl) * LDP + 1536 + v0);
              const float g0 = bflo(gg.x), g1 = bfhi(gg.x), g2 = bflo(gg.y), g3 = bfhi(gg.y);
              const float y0 = o[4 * g] * rstd * ngv[g][0] * (g0 * frcp(1.f + ex2(-LOG2E * g0))), y1 = o[4 * g + 1] * rstd * ngv[g][1] * (g1 * frcp(1.f + ex2(-LOG2E * g1)));
              const float y2 = o[4 * g + 2] * rstd * ngv[g][2] * (g2 * frcp(1.f + ex2(-LOG2E * g2))), y3 = o[4 * g + 3] * rstd * ngv[g][3] * (g3 * frcp(1.f + ex2(-LOG2E * g3)));
              u32x2 wv; wv.x = cvtpk(y0, y1); wv.y = cvtpk(y2, y3);
              *(u32x2*)(ycat + row * DM + 128 * h + v0) = wv; } }
        { const float d0 = BL[32 * kt0 + r], d1 = BL[32 * kt1 + r];
#pragma unroll
          for (int i = 0; i < 16; ++i) { s0[i] *= d0; s1[i] *= d1; }
          const LAS char* vn = lds + H_V + (8 * hi + ((lane & 15) >> 2)) * PV + (32 * vs + 16 * ((lane >> 4) & 1) + 4 * (lane & 3)) * 2;
#pragma unroll
          for (int st = 0; st < 4; ++st) { const s16x4 lo = vtr(vn + (16 * st) * PV), hh = vtr(vn + (16 * st + 4) * PV);
              const bf16x8 a = (bf16x8){lo[0], lo[1], lo[2], lo[3], hh[0], hh[1], hh[2], hh[3]};
              const bf16x8 b0 = *(const LAS bf16x8*)(lds + H_KH + (32 * kt0 + r) * PKH + (16 * st + 8 * hi) * 2), b1 = *(const LAS bf16x8*)(lds + H_KH + (32 * kt1 + r) * PKH + (16 * st + 8 * hi) * 2);
              s0 = MFMA32(a, b0, s0); s1 = MFMA32(a, b1, s1); }
#pragma unroll
          for (int i = 0; i < 16; ++i) { const int v = 32 * vs + crow(i, hi);
              *(LAS bf16_t*)(lds + H_ST + v * P272 + (32 * kt0 + r) * 2) = (bf16_t)cvtpk(s0[i], 0.f); *(LAS bf16_t*)(lds + H_ST + v * P272 + (32 * kt1 + r) * 2) = (bf16_t)cvtpk(s1[i], 0.f); } }
        __syncthreads();
    }
#undef HG_LOAD
}
}
namespace lru {
constexpr int L_XC = 0, L_CW = 8 * 32 * 65 * 4  , L_CB = L_CW + 4 * 64 * 4, L_AS = L_CB + 256, L_HS = L_AS + 8 * 64 * 4, L_END = L_HS + 8 * 64 * 4;
static_assert(L_END <= LDS_MISC, "lru LDS map");
constexpr int LDP = ODD_IN;
__device__ __forceinline__ float gelu_tanh(float x) { const float y = 0.7978845608028654f * (x + 0.044715f * x * x * x); const float t = 1.f - 2.f * frcp(1.f + ex2(2.f * LOG2E * y)); return 0.5f * x * (1.f + t); }

__device__ __forceinline__ void lru_unit(LAS char* lds, const bf16_t* proj, const float* conv_w, const float* conv_b, const float* wa, const float* ba, const float* wx, const float* bx, const float* lam,
                                         float* abuf, float* ubuf, bf16_t* ycat, int b, int n) {
    const int tid = threadIdx.x, lane = tid & 63, r = lane & 31, hi = lane >> 5, w = __builtin_amdgcn_readfirstlane(tid >> 6);
    const int ch0 = 64 * n;
    LAS float* CW = (LAS float*)(lds + L_CW); LAS float* CB = (LAS float*)(lds + L_CB); LAS float* XC = (LAS float*)(lds + L_XC) + w * (32 * 65);
    LAS float* AS = (LAS float*)(lds + L_AS); LAS float* HS = (LAS float*)(lds + L_HS);
    if (tid < 256) CW[tid] = conv_w[(tid >> 6) * 512 + ch0 + (tid & 63)]; else if (tid < 320) CB[tid - 256] = conv_b[ch0 + tid - 256];
    bf16x8 waf[2][4], wxf[2][4];
#pragma unroll
    for (int nt = 0; nt < 2; ++nt)
#pragma unroll
        for (int ks = 0; ks < 4; ++ks) { float va[8], vx[8];
#pragma unroll
            for (int e = 0; e < 8; ++e) { const size_t off = ((size_t)n * 64 + 16 * ks + 8 * hi + e) * 64 + 32 * nt + r; va[e] = wa[off]; vx[e] = wx[off]; }
            u32x4 pa, px; pa.x = cvtpk(va[0], va[1]); pa.y = cvtpk(va[2], va[3]); pa.z = cvtpk(va[4], va[5]); pa.w = cvtpk(va[6], va[7]);
            px.x = cvtpk(vx[0], vx[1]); px.y = cvtpk(vx[2], vx[3]); px.z = cvtpk(vx[4], vx[5]); px.w = cvtpk(vx[6], vx[7]);
            waf[nt][ks] = __builtin_bit_cast(bf16x8, pa); wxf[nt][ks] = __builtin_bit_cast(bf16x8, px); }
    float bav[2], bxv[2], csv[2];
#pragma unroll
    for (int nt = 0; nt < 2; ++nt) { const int c = ch0 + 32 * nt + r; bav[nt] = ba[c]; bxv[nt] = bx[c]; csv[nt] = 8.0f * log1pf(expf(-lam[c])); }
    __syncthreads();
    const bf16_t* pbase = proj + (size_t)(b * SEQ) * LDP + ch0;
    for (int tt = w; tt < SEQ / 32; tt += 8) {
        const int t0 = 32 * tt, trow = t0 + r;
        bf16x8 af[4];
#pragma unroll
        for (int ks = 0; ks < 4; ++ks) { const int c8 = 16 * ks + 8 * hi; float acc[8];
#pragma unroll
            for (int e = 0; e < 8; ++e) acc[e] = CB[c8 + e];
#pragma unroll
            for (int j = 0; j < 4; ++j) { const int tj = trow - 3 + j;
                if (tj >= 0) { const u32x4 xv = *(const u32x4*)(pbase + (size_t)tj * LDP + c8);
                    acc[0] += CW[j * 64 + c8] * bflo(xv.x); acc[1] += CW[j * 64 + c8 + 1] * bfhi(xv.x); acc[2] += CW[j * 64 + c8 + 2] * bflo(xv.y); acc[3] += CW[j * 64 + c8 + 3] * bfhi(xv.y);
                    acc[4] += CW[j * 64 + c8 + 4] * bflo(xv.z); acc[5] += CW[j * 64 + c8 + 5] * bfhi(xv.z); acc[6] += CW[j * 64 + c8 + 6] * bflo(xv.w); acc[7] += CW[j * 64 + c8 + 7] * bfhi(xv.w); } }
#pragma unroll
            for (int e = 0; e < 8; ++e) XC[r * 65 + c8 + e] = acc[e];
            u32x4 pk; pk.x = cvtpk(acc[0], acc[1]); pk.y = cvtpk(acc[2], acc[3]); pk.z = cvtpk(acc[4], acc[5]); pk.w = cvtpk(acc[6], acc[7]);
            af[ks] = __builtin_bit_cast(bf16x8, pk); }
        f32x16 ra0 = f32x16{}, ra1 = f32x16{}, rx0 = f32x16{}, rx1 = f32x16{};
#pragma unroll
        for (int ks = 0; ks < 4; ++ks) { ra0 = MFMA32(af[ks], waf[0][ks], ra0); ra1 = MFMA32(af[ks], waf[1][ks], ra1); rx0 = MFMA32(af[ks], wxf[0][ks], rx0); rx1 = MFMA32(af[ks], wxf[1][ks], rx1); }
        asm volatile("s_waitcnt lgkmcnt(0)" ::: "memory");
#pragma unroll
        for (int nt = 0; nt < 2; ++nt)
#pragma unroll
            for (int i = 0; i < 16; ++i) { const int tl = crow(i, hi); const float xcv = XC[tl * 65 + 32 * nt + r];
                const float rp = (nt ? ra1[i] : ra0[i]) + bav[nt], ip = (nt ? rx1[i] : rx0[i]) + bxv[nt];
                const float rg = frcp(1.f + ex2(-LOG2E * rp)), ig = frcp(1.f + ex2(-LOG2E * ip));
                const float la = -rg * csv[nt];
                const float av = expf(la), uv = sqrtf(-expm1f(2.f * la)) * (ig * xcv);
                const size_t o = (size_t)(b * SEQ + t0 + tl) * 512 + ch0 + 32 * nt + r;
                abuf[o] = av; ubuf[o] = uv; }
    }
    __threadfence_block();
    asm volatile("s_waitcnt vmcnt(0)" ::: "memory");
    __syncthreads();
    const size_t sbase = (size_t)(b * SEQ + 256 * w) * 512 + ch0 + lane;
    { float A = 1.f, Hh = 0.f;
      for (int t = 0; t < 256; t += 8) { float av[8], uv[8];
#pragma unroll
          for (int e = 0; e < 8; ++e) { av[e] = abuf[sbase + (size_t)(t + e) * 512]; uv[e] = ubuf[sbase + (size_t)(t + e) * 512]; }
#pragma unroll
          for (int e = 0; e < 8; ++e) { Hh = av[e] * Hh + uv[e]; A *= av[e]; } }
      AS[w * 64 + lane] = A; HS[w * 64 + lane] = Hh; }
    __syncthreads();
    float hst = 0.f;
#pragma unroll
    for (int ww = 0; ww < 8; ++ww) if (ww < w) hst = AS[ww * 64 + lane] * hst + HS[ww * 64 + lane];
    const bf16_t* gptr = proj + (size_t)(b * SEQ + 256 * w) * LDP + 512 + ch0 + lane;
    bf16_t* optr = ycat + (size_t)(b * SEQ + 256 * w) * DM + ch0 + lane;
    for (int t = 0; t < 256; t += 8) { float av[8], uv[8]; unsigned short gv[8];
#pragma unroll
        for (int e = 0; e < 8; ++e) { av[e] = abuf[sbase + (size_t)(t + e) * 512]; uv[e] = ubuf[sbase + (size_t)(t + e) * 512]; gv[e] = gptr[(size_t)(t + e) * LDP]; }
#pragma unroll
        for (int e = 0; e < 8; ++e) { hst = av[e] * hst + uv[e]; optr[(size_t)(t + e) * DM] = (bf16_t)cvtpk(hst * gelu_tanh(bf2f(gv[e])), 0.f); } }
    __syncthreads();
}
}
#ifndef TG
#define TG 15
#endif
#ifndef TM
#define TM 255
#endif
#ifndef MK_SINGLE
#define MK_SINGLE 1
#endif
constexpr int N_PHASES = 15;
struct Args { const float* in[19]; float* out; unsigned char* ws; int ph_lo, ph_hi; };
typedef const __attribute__((address_space(4))) Args* KArgs;
__device__ __forceinline__ KArgs kargs() { KArgs kp = (KArgs)__builtin_amdgcn_kernarg_segment_ptr(); asm volatile("" : "+s"(kp)); return kp; }

template <class Epi, bool ALIGN, int GBIT>
__device__ __forceinline__ void run_gemm(LAS unsigned char* lds, const bf16_t* A, const bf16_t* Bt, int N, int K, const Epi& E) {
    pg8::Gemm g{A, Bt, MROWS, N, K}; pg8::StaticOrder S; S.init(MROWS, N, (int)gridDim.x, (int)blockIdx.x);
#if TM & 32
    if (TG & GBIT) pg8::gemm_phase<Epi, pg8::StaticOrder, ALIGN, true>(lds, g, S, E);
#endif
}

template <int LAYER>
__device__ __forceinline__ void mixer_phase(LAS unsigned char* lds) {
    const int tid = threadIdx.x;
    LAS int* slot = (LAS int*)(lds + LDS_MISC);
    constexpr int nfirst = LAYER == 0 ? 32 : 64;
    {
        KArgs k = kargs(); unsigned char* ws = k->ws; unsigned* ctr = (unsigned*)(ws + WS_CTL) + 64 + 128 * LAYER;
        for (;;) {
            __syncthreads(); if (tid == 0) *slot = (int)atomicAdd(ctr, 1u); __syncthreads();
            const int u = *slot; if (u >= nfirst) break;
#if TM & 2
            if (LAYER == 0) hg::hgrn_unit((LAS char*)lds, (const bf16_t*)(ws + WS_PROJ), k->in[3], k->in[4], (bf16_t*)(ws + WS_YCAT), u >> 2, u & 3);
#endif
#if TM & 4
            if (LAYER == 1) lru::lru_unit((LAS char*)lds, (const bf16_t*)(ws + WS_PROJ), k->in[7], k->in[8], k->in[9], k->in[10], k->in[11], k->in[12], k->in[13], (float*)(ws + WS_XB), (float*)(ws + WS_LRU_U), (bf16_t*)(ws + WS_YCAT), u >> 3, u & 7);
#endif
        }
    }
    {
        KArgs k = kargs(); unsigned char* ws = k->ws; unsigned* ctr = (unsigned*)(ws + WS_CTL) + 128 + 128 * LAYER;
        for (;;) {
            __syncthreads(); if (tid == 0) *slot = (int)atomicAdd(ctr, 1u); __syncthreads();
            const int i = *slot; if (i >= 512) break;
            const int qb = 7 - (i >> 6), bh = i & 63, b = bh >> 3, h = bh & 7;
            bf16_t* Og = (bf16_t*)(ws + WS_YCAT) + (size_t)(b * SEQ) * DM + 512 + 64 * h;
#if TM & 8
            if (LAYER == 0) { const bf16_t* pr = (const bf16_t*)(ws + WS_PROJ) + (size_t)(b * SEQ) * EVEN_N + 64 * h;
                att::attn_unit<0>((LAS char*)lds, pr + 2048, pr + 2560, pr + 3072, EVEN_N, (const float*)(ws + WS_FB) + (size_t)(b * SEQ) * 8 + h, k->in[2][h], Og, qb); }
#endif
#if TM & 16
            if (LAYER == 1) { const bf16_t* pr = (const bf16_t*)(ws + WS_PROJ) + (size_t)(b * SEQ) * ODD_IN + 64 * h;
                att::attn_unit<1>((LAS char*)lds, pr + 1024, pr + 1536, pr + 2048, ODD_IN, nullptr, 0.f, Og, qb); }
#endif
        }
    }
}

template <int LAYER>
__device__ __forceinline__ void layer_phases(LAS unsigned char* lds, int lo, int hi, int gw, int NGW, int lane) {
#define IN(k) (lo <= (k) && (k) < hi)
#define SEAM(k) do { if (IN(k) && IN((k) + 1)) cg::this_grid().sync(); } while (0)
    constexpr int pb = 1 + 7 * LAYER;
    if (IN(pb)) { KArgs k = kargs(); unsigned char* ws = k->ws;
        pg8::EpiBf16<0> E{(bf16_t*)(ws + WS_PROJ), LAYER == 0 ? EVEN_N : ODD_IN, nullptr, 0, 0, 1.f};
        run_gemm<pg8::EpiBf16<0>, true, 1>(lds, (const bf16_t*)(ws + WS_XB), (const bf16_t*)(ws + (LAYER == 0 ? WS_WIN0 : WS_WIN1)), LAYER == 0 ? EVEN_N : ODD_IN, DM, E); }
    SEAM(pb);
    if (IN(pb + 1)) mixer_phase<LAYER>(lds);
    SEAM(pb + 1);
    if (IN(pb + 2)) { KArgs k = kargs(); unsigned char* ws = k->ws;
        pg8::EpiResid E{LAYER == 0 ? k->in[0] : (const float*)k->out, k->out, DM, ALPHA};
        run_gemm<pg8::EpiResid, false, 2>(lds, (const bf16_t*)(ws + WS_YCAT), (const bf16_t*)(ws + (LAYER == 0 ? WS_WOUT0 : WS_WOUT1)), DM, DM, E); }
    SEAM(pb + 2);
    if (IN(pb + 3)) { KArgs k = kargs(); phase_ln(k->out, k->out, (bf16_t*)(k->ws + WS_XB), k->in[17] + (LAYER * 2) * DM, k->in[18] + (LAYER * 2) * DM, gw, NGW, lane); }
    SEAM(pb + 3);
    if (IN(pb + 4)) { KArgs k = kargs(); unsigned char* ws = k->ws;
        pg8::EpiSwiGLU E{(bf16_t*)(ws + WS_PROJ), DFF};
        run_gemm<pg8::EpiSwiGLU, true, 4>(lds, (const bf16_t*)(ws + WS_XB), (const bf16_t*)(ws + WS_W13 + LAYER * W13_BYTES), DFF2, DM, E); }
    SEAM(pb + 4);
    if (IN(pb + 5)) { KArgs k = kargs(); unsigned char* ws = k->ws;
        pg8::EpiResid E{(const float*)k->out, k->out, DM, ALPHA};
        run_gemm<pg8::EpiResid, false, 8>(lds, (const bf16_t*)(ws + WS_PROJ), (const bf16_t*)(ws + WS_W2 + LAYER * W2_BYTES), DM, DFF, E); }
    SEAM(pb + 5);
    if (IN(pb + 6)) { KArgs k = kargs(); phase_ln(k->out, k->out, LAYER == 0 ? (bf16_t*)(k->ws + WS_XB) : nullptr, k->in[17] + (LAYER * 2 + 1) * DM, k->in[18] + (LAYER * 2 + 1) * DM, gw, NGW, lane); }
    if (LAYER == 0) SEAM(pb + 6);
#undef IN
#undef SEAM
}

__global__ void __launch_bounds__(512, 2) mega_fwd(Args args) {
    extern __shared__ __attribute__((aligned(16))) unsigned char lds_raw[];
    LAS unsigned char* lds = (LAS unsigned char*)lds_raw;
    const int tid = threadIdx.x, lane = tid & 63, wave = __builtin_amdgcn_readfirstlane(tid >> 6);
    const int gw = blockIdx.x * 8 + wave, NGW = gridDim.x * 8;
    const int lo = args.ph_lo, hi = args.ph_hi;
#if TM & 1
    if (lo <= 0 && 0 < hi) { KArgs k = kargs(); P p{k->in[0], k->in[1], k->in[5], k->in[6], k->in[14], k->in[15], k->in[16], k->ws}; phase_prologue(p, lds, gw, NGW, wave, lane, tid); }
#endif
    if (lo <= 0 && 1 < hi) cg::this_grid().sync();
    layer_phases<0>(lds, lo, hi, gw, NGW, lane);
    layer_phases<1>(lds, lo, hi, gw, NGW, lane);
}

extern "C" void kernel_launch(void* const* d_in, const int* in_sizes, int n_in, void* d_out, int out_size, void* d_ws, size_t ws_size, hipStream_t stream) {
    static int grid = 0;
    if (grid == 0) {
        if (n_in != 19 || out_size != MROWS * DM || ws_size < WS_END) { fprintf(stderr, "kernel_launch: unexpected shapes (n_in %d out %d ws %zu)\n", n_in, out_size, ws_size); grid = -1; return; }
        int dev = 0, cus = 0, per_cu = 0;
        (void)hipGetDevice(&dev); (void)hipDeviceGetAttribute(&cus, hipDeviceAttributeMultiprocessorCount, dev);
        if (hipFuncSetAttribute((const void*)mega_fwd, hipFuncAttributeMaxDynamicSharedMemorySize, LDS_BYTES) != hipSuccess) { fprintf(stderr, "kernel_launch: hipFuncSetAttribute failed\n"); }
        if (hipOccupancyMaxActiveBlocksPerMultiprocessor(&per_cu, (const void*)mega_fwd, 512, LDS_BYTES) != hipSuccess || per_cu < 1) per_cu = 1;
        (void)hipGetLastError();
        grid = cus * per_cu; if (grid <= 0) grid = 256;
    }
    if (grid < 0) return;
    (void)hipMemsetAsync((char*)d_ws + WS_CTL, 0, CTL_ZERO_BYTES, stream);
    Args a{};
    for (int i = 0; i < 19; ++i) a.in[i] = (const float*)d_in[i];
    a.out = (float*)d_out; a.ws = (unsigned char*)d_ws;
#if MK_SINGLE
    a.ph_lo = 0; a.ph_hi = N_PHASES;
    void* kargs_[] = {&a};
    hipError_t e = hipLaunchCooperativeKernel((const void*)mega_fwd, dim3(grid), dim3(512), kargs_, LDS_BYTES, stream);
    if (e != hipSuccess) fprintf(stderr, "cooperative launch failed: %s (grid %d)\n", hipGetErrorString(e), grid);
#else
    for (int ph = 0; ph < N_PHASES; ++ph) { a.ph_lo = ph; a.ph_hi = ph + 1; hipLaunchKernelGGL(mega_fwd, dim3(grid), dim3(512), LDS_BYTES, stream, a); }
#endif
}
```

```cpp
#include <hip/hip_runtime.h>
#include <hip/hip_cooperative_groups.h>
#include <cstdio>
#include <cstdint>
namespace cg = cooperative_groups;
#define LAS __attribute__((address_space(3)))
typedef unsigned short bf16_t;
typedef short bf16x8 __attribute__((ext_vector_type(8)));
typedef short s16x4 __attribute__((ext_vector_type(4)));
typedef float f32x4 __attribute__((ext_vector_type(4)));
typedef float f32x16 __attribute__((ext_vector_type(16)));
typedef unsigned u32x4 __attribute__((ext_vector_type(4)));
typedef unsigned u32x2 __attribute__((ext_vector_type(2)));
typedef float f32x2_t __attribute__((ext_vector_type(2)));
typedef __bf16 bf16x2_t __attribute__((ext_vector_type(2)));

constexpr int NB = 8, SEQ = 2048, DM = 1024, MROWS = NB * SEQ;
constexpr int EVEN_IN = 3592, EVEN_N = 3584, ODD_IN = 2560, DFF = 2816, DFF2 = 5632;
constexpr float ALPHA = 1.41421356237309515f;
constexpr float LN_EPS = 1e-5f;
constexpr float LOG2E = 1.4426950408889634f;
constexpr float QK_C2 = 0.125f * 1.4426950408889634f;

constexpr size_t MiB = 1u << 20;
constexpr size_t WS_CTL = 0, CTL_ZERO_BYTES = 65536;
constexpr size_t WS_WIN0 = 2 * MiB, WS_WOUT0 = 9 * MiB, WS_WIN1 = 11 * MiB, WS_WOUT1 = 16 * MiB, WS_W13 = 18 * MiB, WS_W2 = 40 * MiB;
constexpr size_t W13_BYTES = (size_t)DFF2 * DM * 2, W2_BYTES = (size_t)DM * DFF * 2;
constexpr size_t WS_FB = 51 * MiB, WS_XB = 52 * MiB, WS_YCAT = 84 * MiB, WS_PROJ = 116 * MiB, WS_LRU_U = 196 * MiB, WS_END = 228 * MiB;
constexpr int LDS_MISC = 131072, LDS_BYTES = 132096;

__device__ __forceinline__ unsigned cvtpk(float lo, float hi) { f32x2_t v = {lo, hi}; bf16x2_t b = __builtin_convertvector(v, bf16x2_t); return __builtin_bit_cast(unsigned, b); }
__device__ __forceinline__ float bf2f(unsigned short x) { return __uint_as_float(((unsigned)x) << 16); }
__device__ __forceinline__ float bflo(unsigned x) { return __uint_as_float(x << 16); }
__device__ __forceinline__ float bfhi(unsigned x) { return __uint_as_float(x & 0xffff0000u); }
__device__ __forceinline__ float ex2(float x) { return __builtin_amdgcn_exp2f(x); }
__device__ __forceinline__ float lg2(float x) { return __builtin_amdgcn_logf(x); }
__device__ __forceinline__ float frcp(float x) { return __builtin_amdgcn_rcpf(x); }
__device__ __forceinline__ int crow(int i, int hi) { return (i & 3) + 8 * (i >> 2) + 4 * hi; }
__device__ __forceinline__ float wave_sum(float v) {
#pragma unroll
    for (int o = 1; o < 64; o <<= 1) v += __shfl_xor(v, o);
    return v;
}
__device__ __forceinline__ s16x4 vtr(const LAS char* p) { return __builtin_bit_cast(s16x4, __builtin_amdgcn_ds_read_tr16_b64_v4i16((LAS s16x4*)p)); }
__device__ __forceinline__ bf16x8 pack8(const f32x16& p, int b) {
    u32x4 w; w.x = cvtpk(p[b], p[b + 1]); w.y = cvtpk(p[b + 2], p[b + 3]); w.z = cvtpk(p[b + 4], p[b + 5]); w.w = cvtpk(p[b + 6], p[b + 7]);
    return __builtin_bit_cast(bf16x8, w);
}
#define MFMA32(a, b, c) __builtin_amdgcn_mfma_f32_32x32x16_bf16((a), (b), (c), 0, 0, 0)
namespace pg8 {
#define PG8_LAS __attribute__((address_space(3)))
typedef unsigned short bf16_t;
typedef short bf16x8 __attribute__((ext_vector_type(8)));
typedef float f32x4 __attribute__((ext_vector_type(4)));
typedef unsigned u32x4 __attribute__((ext_vector_type(4)));
constexpr int BM = 256, BK = 64, HALF = 128, HTB = HALF * BK * 2  , STAGE_BYTES = 8 * HTB, NXCD = 8, WGM = 8;

__host__ __device__ __forceinline__ int lds_byte(int r, int c) { const int st = (r >> 4) * 2 + (c >> 5), rr = r & 15, cc = c & 31, ob = rr * 64 + cc * 2; return st * 1024 + (ob ^ (((ob >> 9) & 1) << 5)); }
__host__ __device__ __forceinline__ void stage_rc(int b, int& R, int& C) { const int st = b / 1024, sb = b % 1024, swz = sb ^ (((sb >> 9) & 1) << 5); R = (st >> 1) * 16 + swz / 64; C = (st & 1) * 32 + (swz % 64) / 2; }
__host__ __device__ __forceinline__ int perm32(int rho) { const int n = rho >> 4, i = rho & 15; return 8 * (i >> 2) + 4 * n + (i & 3); }

struct Unit { int pm, pn; };
struct Gemm { const bf16_t* A; const bf16_t* Bt; int M, N, K; };

struct StaticOrder {
    int nM, nN, nwg, G, c;
    __host__ __device__ void init(int M, int N, int G_, int c_) { nM = M / BM; nN = N / BM; nwg = nM * nN; G = G_; c = c_; }
    __host__ __device__ bool next(int i, Unit& u) const {
        const long L = (long)i * G + c; if (L >= nwg) return false;
        int wgid = (int)L; { const int q = nwg / NXCD, r = nwg % NXCD, xcd = wgid % NXCD, off = wgid / NXCD; wgid = (xcd < r ? xcd * (q + 1) : r * (q + 1) + (xcd - r) * q) + off; }
        const int nig = WGM * nN, gid = wgid / nig, fm = gid * WGM, gsz = (nM - fm) < WGM ? (nM - fm) : WGM;
        u.pm = fm + ((wgid % nig) % gsz); u.pn = (wgid % nig) / gsz; return true;
    }
    __device__ __forceinline__ void a_ready(const Unit&) const {}
    __device__ __forceinline__ void done(const Unit&) const {}
};

__device__ __forceinline__ unsigned cvt_pk_bf16(float lo, float hi) { unsigned r; asm volatile("v_cvt_pk_bf16_f32 %0, %1, %2" : "=v"(r) : "v"(lo), "v"(hi)); return r; }
typedef float f32x2 __attribute__((ext_vector_type(2)));
__device__ __forceinline__ f32x2 gelu_pk(f32x2 v) {
    const f32x2 av = __builtin_elementwise_abs(v), d = av * 0.2316418882f + 1.0f;
    f32x2 t; t.x = __builtin_amdgcn_rcpf(d.x); t.y = __builtin_amdgcn_rcpf(d.y);
    f32x2 q = t * 0.5307027145f + (-0.7265760135f); q = q * t + 0.7107068705f; q = q * t + (-0.142248368f); q = q * t + 0.127414796f; q = q * t;
    const f32x2 s = (v * v) * (-0.72134752044f);
    f32x2 e; e.x = __builtin_amdgcn_exp2f(s.x); e.y = __builtin_amdgcn_exp2f(s.y);
    const f32x2 m = v * (q * e), r = v - m;
    f32x2 o; o.x = v.x < 0.f ? m.x : r.x; o.y = v.y < 0.f ? m.y : r.y; return o;
}

template <int ACT  > struct EpiBf16 {
    static constexpr bool PERM = true, AFTER_DRAIN = false; static_assert(ACT == 0 || ACT == 1, "EpiBf16: ACT is 0 (none) or 1 (gelu_pk)");
    bf16_t* O; int ldc; const float* bias; int split_cols; size_t split_stride; float scale0;
    __device__ __forceinline__ void operator()(const f32x4 (&acc)[2][2][4][2], const Unit& u, int wr, int wc, int fr, int fq) const {
        const int row0 = u.pm * BM + wr * 64 + fr; int colt = u.pn * BM; bf16_t* base = O;
        float sc = 1.f; if (split_cols) { const int t = colt / split_cols; base += (size_t)t * split_stride; colt -= t * split_cols; if (t == 0) sc = scale0; }
        const int col0 = colt + wc * 32 + 8 * fq, bcol0 = u.pn * BM + wc * 32 + 8 * fq;
        f32x4 bv[2][2];
#pragma unroll
        for (int bj = 0; bj < 2; ++bj)
#pragma unroll
            for (int n = 0; n < 2; ++n) bv[bj][n] = bias ? *(const f32x4*)(bias + bcol0 + bj * HALF + 4 * n) : (f32x4){0.f, 0.f, 0.f, 0.f};
#pragma unroll
        for (int ai = 0; ai < 2; ++ai)
#pragma unroll
            for (int m = 0; m < 4; ++m) { bf16_t* rowp = base + (size_t)(row0 + ai * HALF + m * 16) * ldc + col0;
#pragma unroll
                for (int bj = 0; bj < 2; ++bj) { f32x4 v0 = acc[ai][bj][m][0] + bv[bj][0], v1 = acc[ai][bj][m][1] + bv[bj][1];
                    if (ACT == 1) { f32x2 a = gelu_pk((f32x2){v0[0], v0[1]}), b = gelu_pk((f32x2){v0[2], v0[3]}), c = gelu_pk((f32x2){v1[0], v1[1]}), d = gelu_pk((f32x2){v1[2], v1[3]});
                        v0 = (f32x4){a.x, a.y, b.x, b.y}; v1 = (f32x4){c.x, c.y, d.x, d.y}; }
                    v0 = v0 * sc; v1 = v1 * sc; u32x4 w; w.x = cvt_pk_bf16(v0[0], v0[1]); w.y = cvt_pk_bf16(v0[2], v0[3]); w.z = cvt_pk_bf16(v1[0], v1[1]); w.w = cvt_pk_bf16(v1[2], v1[3]);
                    *(u32x4*)(rowp + bj * HALF) = w; } }
    }
};
struct EpiResid {
    static constexpr bool PERM = false, AFTER_DRAIN = false;
    const float* base; float* out; int ldc; float alpha;
    __device__ __forceinline__ void operator()(const f32x4 (&acc)[2][2][4][2], const Unit& u, int wr, int wc, int fr, int fq) const {
        const int row0 = u.pm * BM + wr * 64 + fr, col0 = u.pn * BM + wc * 32 + 4 * fq;
#pragma unroll
        for (int ai = 0; ai < 2; ++ai)
#pragma unroll
            for (int m = 0; m < 4; ++m) { const size_t off = (size_t)(row0 + ai * HALF + m * 16) * ldc + col0;
#pragma unroll
                for (int bj = 0; bj < 2; ++bj)
#pragma unroll
                    for (int n = 0; n < 2; ++n) { const f32x4 bs = *(const f32x4*)(base + off + bj * HALF + n * 16); *(f32x4*)(out + off + bj * HALF + n * 16) = bs * alpha + acc[ai][bj][m][n]; } }
    }
};
struct EpiSwiGLU {
    static constexpr bool PERM = true, AFTER_DRAIN = false;
    bf16_t* H; int ldh;
    __device__ __forceinline__ void operator()(const f32x4 (&acc)[2][2][4][2], const Unit& u, int wr, int wc, int fr, int fq) const {
        const int row0 = u.pm * BM + wr * 64 + fr, col0 = u.pn * HALF + wc * 32 + 8 * fq;
#pragma unroll
        for (int ai = 0; ai < 2; ++ai)
#pragma unroll
            for (int m = 0; m < 4; ++m) { bf16_t* rowp = H + (size_t)(row0 + ai * HALF + m * 16) * ldh + col0;
                float hv[8];
#pragma unroll
                for (int n = 0; n < 2; ++n)
#pragma unroll
                    for (int i = 0; i < 4; ++i) { const float a = acc[ai][0][m][n][i], b = acc[ai][1][m][n][i];
                        hv[4 * n + i] = a * __builtin_amdgcn_rcpf(1.0f + __builtin_amdgcn_exp2f(-1.4426950408889634f * a)) * b; }
                u32x4 w; w.x = cvt_pk_bf16(hv[0], hv[1]); w.y = cvt_pk_bf16(hv[2], hv[3]); w.z = cvt_pk_bf16(hv[4], hv[5]); w.w = cvt_pk_bf16(hv[6], hv[7]);
                *(u32x4*)rowp = w; }
    }
};
template <class Epi, class Sched, bool ALIGN_EPI = false, bool SP2 = false>
__device__ __forceinline__ void gemm_phase(PG8_LAS unsigned char* lds, const Gemm g, const Sched& S, const Epi& E) {
    const int tid = threadIdx.x, wid = __builtin_amdgcn_readfirstlane(tid >> 6), lane = tid & 63, wr = wid >> 2, wc = wid & 3, fr = lane & 15, fq = lane >> 4;
    const int K = g.K, nt = K / BK;
    unsigned voffA[2], voffB[2];
#pragma unroll
    for (int i = 0; i < 2; ++i) { int R, C; stage_rc(tid * 16 + i * 8192, R, C); const int Rb = Epi::PERM ? ((R & ~31) + perm32(R & 31)) : R;
        voffA[i] = (unsigned)(R * K + C) * 2u; voffB[i] = (unsigned)(Rb * K + C) * 2u; }
    const size_t kstep = (size_t)(BK * 2);
    const size_t hstep = (size_t)HALF * K * 2;
    const size_t tstep = 2 * hstep;
    const unsigned ldsw = (unsigned)wid * 1024u;
    const int aoff = lds_byte(wr * 64 + fr, fq * 8), boff = lds_byte(wc * 32 + fr, fq * 8);
#define PG8_SA(b, h) (((b) * 2 + (h)) * HTB)
#define PG8_SB(b, h) ((4 + (b) * 2 + (h)) * HTB)
#define PG8_STAGE(bufoff, gbase, voff) do { _Pragma("unroll") for (int _i = 0; _i < 2; ++_i) \
        __builtin_amdgcn_global_load_lds((const unsigned*)((const char*)(gbase) + (voff)[_i]), (PG8_LAS unsigned*)(lds + (bufoff) + ldsw + _i * 8192), 16, 0, 0); } while (0)
#define PG8_LDA(dst, b, h) do { _Pragma("unroll") for (int m = 0; m < 4; ++m) _Pragma("unroll") for (int k = 0; k < 2; ++k) dst[m][k] = *(const PG8_LAS bf16x8*)(lds + PG8_SA(b, h) + aoff + m * 2048 + k * 1024); } while (0)
#define PG8_LDB(dst, b, h) do { _Pragma("unroll") for (int n = 0; n < 2; ++n) _Pragma("unroll") for (int k = 0; k < 2; ++k) dst[n][k] = *(const PG8_LAS bf16x8*)(lds + PG8_SB(b, h) + boff + n * 2048 + k * 1024); } while (0)
#define PG8_MMA(ai, bj, At, Bt) do { __builtin_amdgcn_s_setprio(1); _Pragma("unroll") for (int m = 0; m < 4; ++m) _Pragma("unroll") for (int n = 0; n < 2; ++n) _Pragma("unroll") for (int k = 0; k < 2; ++k) \
        acc[ai][bj][m][n] = __builtin_amdgcn_mfma_f32_16x16x32_bf16(Bt[n][k], At[m][k], acc[ai][bj][m][n], 0, 0, 0); __builtin_amdgcn_s_setprio(0); } while (0)
#define PG8_WAIT_V(n) asm volatile("s_waitcnt vmcnt(" #n ")" ::: "memory")
#define PG8_WAIT_L(n) asm volatile("s_waitcnt lgkmcnt(" #n ")" ::: "memory")
#define PG8_BAR __builtin_amdgcn_s_barrier()
#define PG8_SCHED __builtin_amdgcn_sched_barrier(0)
    Unit cur, nxt; int ui = 0;
    if (!S.next(0, cur)) return;
    f32x4 acc[2][2][4][2];
#pragma unroll
    for (int a = 0; a < 2; ++a)
#pragma unroll
        for (int b = 0; b < 2; ++b)
#pragma unroll
            for (int m = 0; m < 4; ++m)
#pragma unroll
                for (int n = 0; n < 2; ++n) acc[a][b][m][n] = (f32x4){0.f, 0.f, 0.f, 0.f};
    bf16x8 At[4][2], B0[2][2], B1[2][2];
    const char* cA = (const char*)g.A + (size_t)cur.pm * tstep; const char* cB = (const char*)g.Bt + (size_t)cur.pn * tstep;
    S.a_ready(cur);
    if constexpr (SP2) {
        PG8_STAGE(PG8_SB(0, 0), cB, voffB); PG8_STAGE(PG8_SB(0, 1), cB + hstep, voffB); PG8_STAGE(PG8_SA(0, 0), cA, voffA); PG8_STAGE(PG8_SA(0, 1), cA + hstep, voffA);
        if (wr == 1) PG8_BAR;
        PG8_WAIT_V(2); PG8_BAR;
        PG8_STAGE(PG8_SB(1, 0), cB + kstep, voffB); PG8_STAGE(PG8_SA(1, 0), cA + kstep, voffA); PG8_STAGE(PG8_SB(1, 1), cB + hstep + kstep, voffB);
        PG8_WAIT_V(6); PG8_BAR;
    } else {
        PG8_STAGE(PG8_SB(0, 0), cB, voffB); PG8_STAGE(PG8_SA(0, 0), cA, voffA); PG8_STAGE(PG8_SB(0, 1), cB + hstep, voffB); PG8_STAGE(PG8_SA(0, 1), cA + hstep, voffA);
        if (wr == 1) PG8_BAR;
        PG8_WAIT_V(4); PG8_BAR;
        PG8_STAGE(PG8_SB(1, 0), cB + kstep, voffB); PG8_STAGE(PG8_SA(1, 0), cA + kstep, voffA); PG8_STAGE(PG8_SB(1, 1), cB + hstep + kstep, voffB);
        PG8_WAIT_V(6); PG8_BAR;
    }
    for (;;) {
        const bool has_next = S.next(ui + 1, nxt);
        const char* nA = has_next ? (const char*)g.A + (size_t)nxt.pm * tstep : cA; const char* nB = has_next ? (const char*)g.Bt + (size_t)nxt.pn * tstep : cB;
        for (int t = 0; t < nt; t += 2) {
            const bool last = (t == nt - 2);
            const char* a1 = cA + (size_t)(t + 1) * kstep;
            const char* a2 = last ? nA : cA + (size_t)(t + 2) * kstep; const char* b2 = last ? nB : cB + (size_t)(t + 2) * kstep;
            const char* a3 = a2 + kstep; const char* b3 = b2 + kstep;
            if (last && has_next) S.a_ready(nxt);
            if constexpr (SP2) {
            PG8_LDB(B0, 0, 0); PG8_LDB(B1, 0, 1); PG8_SCHED; PG8_LDA(At, 0, 0); PG8_STAGE(PG8_SA(1, 1), a1 + hstep, voffA);
            PG8_WAIT_V(8); PG8_WAIT_L(0); PG8_BAR; PG8_MMA(0, 0, At, B0); PG8_MMA(0, 1, At, B1); PG8_BAR; PG8_SCHED;
            PG8_LDA(At, 0, 1); PG8_STAGE(PG8_SB(0, 0), b2, voffB); PG8_STAGE(PG8_SB(0, 1), b2 + hstep, voffB); PG8_STAGE(PG8_SA(0, 0), a2, voffA);
            PG8_WAIT_V(8); PG8_WAIT_L(0); PG8_BAR; PG8_MMA(1, 0, At, B0); PG8_MMA(1, 1, At, B1); PG8_BAR; PG8_SCHED;
            PG8_LDB(B0, 1, 0); PG8_LDB(B1, 1, 1); PG8_SCHED; PG8_LDA(At, 1, 0); PG8_STAGE(PG8_SA(0, 1), a2 + hstep, voffA);
            PG8_WAIT_V(8); PG8_WAIT_L(0); PG8_BAR; PG8_MMA(0, 0, At, B0); PG8_MMA(0, 1, At, B1); PG8_BAR; PG8_SCHED;
            PG8_LDA(At, 1, 1); PG8_STAGE(PG8_SB(1, 0), b3, voffB); PG8_STAGE(PG8_SB(1, 1), b3 + hstep, voffB); PG8_STAGE(PG8_SA(1, 0), a3, voffA);
            PG8_WAIT_V(8); PG8_WAIT_L(0); PG8_BAR; PG8_MMA(1, 0, At, B0); PG8_MMA(1, 1, At, B1); PG8_BAR; PG8_SCHED;
            } else {
            PG8_LDB(B0, 0, 0); PG8_SCHED; PG8_LDA(At, 0, 0); PG8_STAGE(PG8_SA(1, 1), a1 + hstep, voffA);
            PG8_WAIT_L(8); PG8_BAR; PG8_WAIT_L(0); PG8_MMA(0, 0, At, B0); PG8_BAR; PG8_SCHED;
            PG8_LDB(B1, 0, 1); PG8_STAGE(PG8_SB(0, 0), b2, voffB);
            PG8_BAR; PG8_WAIT_L(0); PG8_MMA(0, 1, At, B1); PG8_BAR;
            PG8_LDA(At, 0, 1); PG8_STAGE(PG8_SA(0, 0), a2, voffA);
            PG8_BAR; PG8_WAIT_L(0); PG8_MMA(1, 0, At, B0); PG8_BAR; PG8_SCHED;
            PG8_STAGE(PG8_SB(0, 1), b2 + hstep, voffB);
            PG8_WAIT_V(6); PG8_BAR; PG8_MMA(1, 1, At, B1); PG8_BAR;
            PG8_LDB(B0, 1, 0); PG8_SCHED; PG8_LDA(At, 1, 0); PG8_STAGE(PG8_SA(0, 1), a2 + hstep, voffA);
            PG8_WAIT_L(8); PG8_BAR; PG8_WAIT_L(0); PG8_MMA(0, 0, At, B0); PG8_BAR; PG8_SCHED;
            PG8_LDB(B1, 1, 1); PG8_STAGE(PG8_SB(1, 0), b3, voffB);
            PG8_BAR; PG8_WAIT_L(0); PG8_MMA(0, 1, At, B1); PG8_BAR;
            PG8_LDA(At, 1, 1); PG8_STAGE(PG8_SA(1, 0), a3, voffA);
            PG8_BAR; PG8_WAIT_L(0); PG8_MMA(1, 0, At, B0); PG8_BAR; PG8_SCHED;
            PG8_STAGE(PG8_SB(1, 1), b3 + hstep, voffB);
            PG8_WAIT_V(6); PG8_BAR; PG8_MMA(1, 1, At, B1); PG8_BAR;
            }
        }
        if constexpr (ALIGN_EPI) { if (wr == 0) PG8_BAR; }
        if constexpr (!Epi::AFTER_DRAIN) { E(acc, cur, wr, wc, fr, fq); S.done(cur); }
        if (!has_next) break;
#pragma unroll
        for (int a = 0; a < 2; ++a)
#pragma unroll
            for (int b = 0; b < 2; ++b)
#pragma unroll
                for (int m = 0; m < 4; ++m)
#pragma unroll
                    for (int n = 0; n < 2; ++n) acc[a][b][m][n] = (f32x4){0.f, 0.f, 0.f, 0.f};
        cur = nxt; cA = nA; cB = nB; ++ui;
        if constexpr (ALIGN_EPI) { if (wr == 1) PG8_BAR; }
    }
    PG8_WAIT_V(0);
    if constexpr (!ALIGN_EPI) { if (wr == 0) PG8_BAR; }
    PG8_BAR;
    if constexpr (Epi::AFTER_DRAIN) { E.fused(acc, cur, wr, wc, fr, fq, lds, wid, lane); S.done(cur); }
#undef PG8_SA
#undef PG8_SB
#undef PG8_STAGE
#undef PG8_LDA
#undef PG8_LDB
#undef PG8_MMA
#undef PG8_WAIT_V
#undef PG8_WAIT_L
#undef PG8_BAR
#undef PG8_SCHED
}
}
typedef unsigned v4u __attribute__((ext_vector_type(4)));
#define XB_TMO      128
#define XB_XCNT(j)  (256  + 64 * (j))
#define XB_XSUB(j)  (1280 + 64 * (j))
#define XB_XGEN(j)  (2304 + 64 * (j))
#define XB_TOP      3328
#define XB_TOPGEN   3392
#define XCD_BAR_WORDS 3456
#define XB_SPIN_CAP (1u << 18)

__device__ __forceinline__ unsigned xb_ld(unsigned* p)              { return __hip_atomic_load(p, __ATOMIC_RELAXED, __HIP_MEMORY_SCOPE_AGENT); }
__device__ __forceinline__ unsigned xb_add(unsigned* p, unsigned v) { return __hip_atomic_fetch_add(p, v, __ATOMIC_RELAXED, __HIP_MEMORY_SCOPE_AGENT); }
__device__ __forceinline__ unsigned xb_xcc_id() { return (unsigned)__builtin_amdgcn_s_getreg((3 << 11) | 20) & 0xFu; }
#define XB_SPIN(cond, bar) do { unsigned _sp = 0; while (cond) { __builtin_amdgcn_s_sleep(1); \
    if ((++_sp & 255u) == 0u) { if (xb_ld(&(bar)[XB_TMO])) break; if (_sp > XB_SPIN_CAP) { atomicAdd(&(bar)[XB_TMO], 1u); break; } } } } while (0)

struct XcdBarrier {
    unsigned* bar; unsigned x;
    volatile LAS unsigned* st;
};

__device__ __forceinline__ XcdBarrier xcd_barrier_post(unsigned* bar, volatile LAS unsigned* st) {
    XcdBarrier b; b.bar = bar; b.x = xb_xcc_id(); b.st = st;
    if (threadIdx.x == 0) (void)xb_add(&bar[XB_XCNT(b.x)], 1u);
    return b;
}
__device__ __forceinline__ void xcd_barrier_complete(unsigned* bar, unsigned x, unsigned& nloc, unsigned& nx) {
    const unsigned G = gridDim.x * gridDim.y * gridDim.z;
    unsigned sum, cnt, mine, sp = 0u;
    for (;;) {
        sum = 0u; cnt = 0u; mine = 0u;
#pragma unroll
        for (unsigned j = 0; j < 16; ++j) { const unsigned c = xb_ld(&bar[XB_XCNT(j)]); sum += c; cnt += (c > 0u) ? 1u : 0u; mine = (j == x) ? c : mine; }
        if (sum == G) break;
        __builtin_amdgcn_s_sleep(1);
        if ((++sp & 255u) == 0u) { if (xb_ld(&bar[XB_TMO])) break; if (sp > XB_SPIN_CAP) { atomicAdd(&bar[XB_TMO], 1u); break; } }
    }
    nloc = mine > 0u ? mine : 1u; nx = cnt > 0u ? cnt : 1u;
}

__device__ __forceinline__ void xcd_barrier(const XcdBarrier& b) {
    asm volatile("s_waitcnt vmcnt(0)" ::: "memory");
    __syncthreads();
    if (threadIdx.x == 0) {
        unsigned* bar = b.bar;
        __builtin_amdgcn_s_waitcnt(0);
        unsigned nloc = b.st[0], nx = b.st[1];
        if (nloc == 0u) { xcd_barrier_complete(bar, b.x, nloc, nx); b.st[0] = nloc; b.st[1] = nx; }
        const unsigned old = xb_add(&bar[XB_XSUB(b.x)], 1u);
        const unsigned gen = old / nloc;
        if (old + 1u == (gen + 1u) * nloc) {
            __builtin_amdgcn_fence(__ATOMIC_RELEASE, "agent");
            asm volatile("s_waitcnt vmcnt(0)" ::: "memory");
            const unsigned og = xb_add(&bar[XB_TOP], 1u);
            const unsigned tg = og / nx;
            if (og + 1u == (tg + 1u) * nx) xb_add(&bar[XB_TOPGEN], 1u);
            else XB_SPIN(xb_ld(&bar[XB_TOPGEN]) == tg, bar);
            __builtin_amdgcn_fence(__ATOMIC_ACQUIRE, "agent");
            xb_add(&bar[XB_XGEN(b.x)], 1u);
            asm volatile("s_waitcnt vmcnt(0)" ::: "memory");
        } else {
            XB_SPIN(xb_ld(&bar[XB_XGEN(b.x)]) == gen, bar);
            __builtin_amdgcn_fence(__ATOMIC_ACQUIRE, "agent");
            asm volatile("s_waitcnt vmcnt(0)" ::: "memory");
        }
    }
    __syncthreads();
}
__device__ __forceinline__ void p0_transpose_item(const float* W, int ldw, int K, int nblk, bf16_t* WT, int mode, LAS float* scr, int item, int lane) {
    const int kb = item / nblk, nb = item % nblk, k0 = 64 * kb, n0 = 32 * nb;
#pragma unroll 8
    for (int i = 0; i < 32; ++i) { const int kk = 2 * i + (lane >> 5); scr[kk * 33 + (lane & 31)] = W[(size_t)(k0 + kk) * ldw + n0 + (lane & 31)]; }
    asm volatile("s_waitcnt lgkmcnt(0)" ::: "memory");
    int r0 = n0;
    if (mode == 1) { const int half = n0 >= DFF ? 1 : 0; const int j = n0 - half * DFF; r0 = 256 * (j >> 7) + 128 * half + (j & 127); }
    const int c = lane & 7;
#pragma unroll
    for (int j = 0; j < 4; ++j) { const int n = (lane >> 3) + 8 * j; const LAS float* s = scr + (8 * c) * 33 + n;
        u32x4 o; o.x = cvtpk(s[0 * 33], s[1 * 33]); o.y = cvtpk(s[2 * 33], s[3 * 33]); o.z = cvtpk(s[4 * 33], s[5 * 33]); o.w = cvtpk(s[6 * 33], s[7 * 33]);
        *(u32x4*)(WT + (size_t)(r0 + n) * K + k0 + 8 * c) = o; }
    asm volatile("s_waitcnt lgkmcnt(0)" ::: "memory");
}

struct P { const float *x, *ev_w_in, *ev_w_out, *od_w_in, *od_w_out, *w13, *w2; unsigned char* ws; };

__device__ __forceinline__ void phase_prologue(const P& p, LAS unsigned char* lds, int gw, int NGW, int wave, int lane, int tid) {
    LAS float* scr = (LAS float*)(lds + wave * 8704);
    LAS float* fbw = (LAS float*)(lds + 69632);
    for (int i = tid; i < 1024 * 8; i += 512) fbw[i] = p.ev_w_in[(size_t)(i >> 3) * EVEN_IN + EVEN_N + (i & 7)];
    constexpr int I0 = 16 * (EVEN_N / 32), I1 = 16 * 32, I2 = 16 * (ODD_IN / 32), I3 = 16 * 32, I4 = 16 * (DFF2 / 32), I5 = (DFF / 64) * 32;
    constexpr int NITEMS = I0 + I1 + I2 + I3 + 2 * I4 + 2 * I5;
    for (int it = gw; it < NITEMS; it += NGW) {
        int r = it;
        if (r < I0) { p0_transpose_item(p.ev_w_in, EVEN_IN, DM, EVEN_N / 32, (bf16_t*)(p.ws + WS_WIN0), 0, scr, r, lane); continue; } r -= I0;
        if (r < I1) { p0_transpose_item(p.ev_w_out, DM, DM, 32, (bf16_t*)(p.ws + WS_WOUT0), 0, scr, r, lane); continue; } r -= I1;
        if (r < I2) { p0_transpose_item(p.od_w_in, ODD_IN, DM, ODD_IN / 32, (bf16_t*)(p.ws + WS_WIN1), 0, scr, r, lane); continue; } r -= I2;
        if (r < I3) { p0_transpose_item(p.od_w_out, DM, DM, 32, (bf16_t*)(p.ws + WS_WOUT1), 0, scr, r, lane); continue; } r -= I3;
        if (r < 2 * I4) { const int l = r / I4; p0_transpose_item(p.w13 + (size_t)l * DM * DFF2, DFF2, DM, DFF2 / 32, (bf16_t*)(p.ws + WS_W13 + l * W13_BYTES), 1, scr, r % I4, lane); continue; } r -= 2 * I4;
        { const int l = r / I5; p0_transpose_item(p.w2 + (size_t)l * DFF * DM, DM, DFF, 32, (bf16_t*)(p.ws + WS_W2 + l * W2_BYTES), 0, scr, r % I5, lane); }
    }
        __syncthreads();
    bf16_t* XB = (bf16_t*)(p.ws + WS_XB); float* FB = (float*)(p.ws + WS_FB);
    for (int m = gw; m < MROWS; m += NGW) {
        const f32x4* xr = (const f32x4*)(p.x + (size_t)m * DM) + lane;
        f32x4 v[4];
#pragma unroll
        for (int j = 0; j < 4; ++j) v[j] = xr[64 * j];
        unsigned long long* o8 = (unsigned long long*)(XB + (size_t)m * DM) + lane;
        float fa[8];
#pragma unroll
        for (int h = 0; h < 8; ++h) fa[h] = 0.f;
#pragma unroll
        for (int j = 0; j < 4; ++j) {
            o8[64 * j] = (unsigned long long)cvtpk(v[j].x, v[j].y) | ((unsigned long long)cvtpk(v[j].z, v[j].w) << 32);
#pragma unroll
            for (int c = 0; c < 4; ++c) { const int k = 4 * (lane + 64 * j) + c; const f32x4 w0 = *(const LAS f32x4*)(fbw + 8 * k), w1 = *(const LAS f32x4*)(fbw + 8 * k + 4); const float xv = v[j][c];
                fa[0] += xv * w0.x; fa[1] += xv * w0.y; fa[2] += xv * w0.z; fa[3] += xv * w0.w; fa[4] += xv * w1.x; fa[5] += xv * w1.y; fa[6] += xv * w1.z; fa[7] += xv * w1.w; }
        }
#pragma unroll
        for (int h = 0; h < 8; ++h) fa[h] = wave_sum(fa[h]);
        if (lane == 0) { *(f32x4*)(FB + (size_t)m * 8) = (f32x4){fa[0], fa[1], fa[2], fa[3]}; *(f32x4*)(FB + (size_t)m * 8 + 4) = (f32x4){fa[4], fa[5], fa[6], fa[7]}; }
    }
}

__device__ __forceinline__ void phase_ln(const float* y, float* xo, bf16_t* xb, const float* g, const float* b, int gw, int NGW, int lane) {
    f32x4 gv[4], bv[4];
#pragma unroll
    for (int j = 0; j < 4; ++j) { gv[j] = ((const f32x4*)g)[lane + 64 * j]; bv[j] = ((const f32x4*)b)[lane + 64 * j]; }
    for (int m = gw; m < MROWS; m += NGW) {
        const f32x4* yr = (const f32x4*)(y + (size_t)m * DM) + lane;
        f32x4 v[4]; float s = 0.f;
#pragma unroll
        for (int j = 0; j < 4; ++j) { v[j] = yr[64 * j]; s += (v[j].x + v[j].y) + (v[j].z + v[j].w); }
        const float mean = wave_sum(s) * (1.f / DM); float s2 = 0.f;
#pragma unroll
        for (int j = 0; j < 4; ++j) { v[j] = v[j] - mean; s2 += (v[j].x * v[j].x + v[j].y * v[j].y) + (v[j].z * v[j].z + v[j].w * v[j].w); }
        const float rstd = __builtin_amdgcn_rsqf(wave_sum(s2) * (1.f / DM) + LN_EPS);
        f32x4* xr = (f32x4*)(xo + (size_t)m * DM) + lane;
        unsigned long long* o8 = xb ? (unsigned long long*)(xb + (size_t)m * DM) + lane : nullptr;
#pragma unroll
        for (int j = 0; j < 4; ++j) { const f32x4 o = v[j] * rstd * gv[j] + bv[j]; xr[64 * j] = o;
            if (xb) o8[64 * j] = (unsigned long long)cvtpk(o.x, o.y) | ((unsigned long long)cvtpk(o.z, o.w) << 32); }
    }
}
namespace att {
constexpr int KP = 144, VP = 192, KBUF = 64 * KP, VBUF = 64 * VP;
constexpr int OFF_K = 0, OFF_V = 2 * KBUF, OFF_C = OFF_V + 2 * VBUF, OFF_SCAN = OFF_C + 2048 * 4;
static_assert(OFF_SCAN + 64 <= LDS_MISC, "attention LDS map");

__device__ __forceinline__ void qkt(f32x16& p0, f32x16& p1, const LAS char* Kb, const bf16x8 (&qr)[4], int r, int hi) {
    p0 = f32x16{}; p1 = f32x16{};
#pragma unroll
    for (int ks = 0; ks < 4; ++ks) {
        const bf16x8 k0 = *(const LAS bf16x8*)(Kb + r * KP + (16 * ks + 8 * hi) * 2);
        const bf16x8 k1 = *(const LAS bf16x8*)(Kb + (32 + r) * KP + (16 * ks + 8 * hi) * 2);
        p0 = MFMA32(k0, qr[ks], p0); p1 = MFMA32(k1, qr[ks], p1);
    }
}
__device__ __forceinline__ void pv(f32x16& o0, f32x16& o1, const LAS char* Vb, const bf16x8 (&pb)[4], int lane, int hi) {
    const LAS char* vb = Vb + (4 * hi + ((lane & 15) >> 2)) * VP + (16 * ((lane >> 4) & 1) + 4 * (lane & 3)) * 2;
#pragma unroll
    for (int st = 0; st < 4; ++st) {
#pragma unroll
        for (int dt = 0; dt < 2; ++dt) {
            const s16x4 lo = vtr(vb + (16 * st) * VP + 64 * dt), hh = vtr(vb + (16 * st + 8) * VP + 64 * dt);
            const bf16x8 a = (bf16x8){lo[0], lo[1], lo[2], lo[3], hh[0], hh[1], hh[2], hh[3]};
            if (dt == 0) o0 = MFMA32(a, pb[st], o0); else o1 = MFMA32(a, pb[st], o1);
        }
    }
}
__device__ __forceinline__ void store_o(bf16_t* orow, const f32x16& o0, const f32x16& o1, float sc, int hi) {
#pragma unroll
    for (int dt = 0; dt < 2; ++dt)
#pragma unroll
        for (int g = 0; g < 4; ++g) { const f32x16& o = dt ? o1 : o0; u32x2 w; w.x = cvtpk(o[4 * g] * sc, o[4 * g + 1] * sc); w.y = cvtpk(o[4 * g + 2] * sc, o[4 * g + 3] * sc);
            *(u32x2*)(orow + 32 * dt + 8 * g + 4 * hi) = w; }
}

template <int MODE>
__device__ __forceinline__ void attn_unit(LAS char* lds, const bf16_t* Qg, const bf16_t* Kg, const bf16_t* Vg, int ldp, const float* fbcol  , float fbias, bf16_t* Og  , int qb) {
    const int tid = threadIdx.x, lane = tid & 63, r = lane & 31, hi = lane >> 5, w = __builtin_amdgcn_readfirstlane(tid >> 6);
    const int q0 = qb * 256, q1 = q0 + 256, NT = q1 / 64;
    LAS float* C = (LAS float*)(lds + OFF_C);
    if (MODE == 0) {
        LAS float* SC = (LAS float*)(lds + OFF_SCAN);
        float v[4]; float loc = 0.f;
#pragma unroll
        for (int e = 0; e < 4; ++e) { const int s = 4 * tid + e; float ls = 0.f;
            if (s < q1) { const float xx = fbcol[(size_t)s * 8] + fbias; ls = fminf(xx, 0.f) - log1pf(expf(-fabsf(xx))); }
            loc += ls; v[e] = loc; }
        float inc = loc;
#pragma unroll
        for (int o = 1; o < 64; o <<= 1) { const float t = __shfl_up(inc, o); if (lane >= o) inc += t; }
        if (lane == 63) SC[w] = inc;
        __syncthreads();
        float pre = inc - loc;
#pragma unroll
        for (int ww = 0; ww < 8; ++ww) if (ww < w) pre += SC[ww];
#pragma unroll
        for (int e = 0; e < 4; ++e) C[4 * tid + e] = (pre + v[e]) * LOG2E;
    }
    const int trow = q0 + 32 * w + r;
    bf16x8 qr[4];
#pragma unroll
    for (int ks = 0; ks < 4; ++ks) qr[ks] = *(const bf16x8*)(Qg + (size_t)trow * ldp + 16 * ks + 8 * hi);
    const int lr = tid >> 3, lc = tid & 7;
    const bf16_t* kptr = Kg + (size_t)lr * ldp + 8 * lc; const bf16_t* vptr = Vg + (size_t)lr * ldp + 8 * lc;
    LAS char* kst = lds + OFF_K + lr * KP + lc * 16; LAS char* vst = lds + OFF_V + lr * VP + lc * 16;
    const int jfirst = (MODE == 0) ? 0 : NT - 1, jstep = (MODE == 0) ? 1 : -1;
    u32x4 kreg = *(const u32x4*)(kptr + (size_t)(64 * jfirst) * ldp), vreg = *(const u32x4*)(vptr + (size_t)(64 * jfirst) * ldp);
    *(LAS u32x4*)kst = kreg; *(LAS u32x4*)vst = vreg;
    __syncthreads();
    const float ct = (MODE == 0) ? C[trow] : 0.f;
    float m = -1e30f, l = 0.f, R = 0.f;
    f32x16 o0 = f32x16{}, o1 = f32x16{};
    const int tmax_w = q0 + 32 * w + 31, tmin_w = q0 + 32 * w;
    for (int it = 0; it < NT; ++it) {
        const int j = jfirst + jstep * it, buf = it & 1;
        const bool more = it + 1 < NT;
        if (more) { const int jn = j + jstep; kreg = *(const u32x4*)(kptr + (size_t)(64 * jn) * ldp); vreg = *(const u32x4*)(vptr + (size_t)(64 * jn) * ldp); }
        if (64 * j <= tmax_w) {
            const LAS char* Kb = lds + OFF_K + buf * KBUF; const LAS char* Vb = lds + OFF_V + buf * VBUF;
            f32x16 p0, p1; qkt(p0, p1, Kb, qr, r, hi);
            const int sb = 64 * j + 4 * hi;
            const bool diag = (64 * j + 63 > tmin_w - (MODE == 1 ? 1 : 0)) || (MODE == 1 && 64 * j + 63 >= tmin_w);
            bf16x8 pb[4];
            if (MODE == 0) {
                float mx = -1e30f;
#pragma unroll
                for (int i = 0; i < 16; ++i) { const int s = sb + (i & 3) + 8 * (i >> 2);
                    float x0 = p0[i] * QK_C2 + (ct - C[s]), x1 = p1[i] * QK_C2 + (ct - C[s + 32]);
                    if (diag) { if (s > trow) x0 = -INFINITY; if (s + 32 > trow) x1 = -INFINITY; }
                    p0[i] = x0; p1[i] = x1; mx = fmaxf(mx, fmaxf(x0, x1)); }
                mx = fmaxf(mx, __shfl_xor(mx, 32));
                const float mn = fmaxf(m, mx), al = ex2(m - mn); m = mn;
                float sum = 0.f;
#pragma unroll
                for (int i = 0; i < 16; ++i) { p0[i] = ex2(p0[i] - mn); p1[i] = ex2(p1[i] - mn); sum += p0[i] + p1[i]; }
                l = l * al + sum;
#pragma unroll
                for (int i = 0; i < 16; ++i) { o0[i] *= al; o1[i] *= al; }
            } else {
                f32x16 L0, L1;
#pragma unroll
                for (int i = 0; i < 16; ++i) { const int s = sb + (i & 3) + 8 * (i >> 2);
                    const float z0 = p0[i] * QK_C2, z1 = p1[i] * QK_C2;
                    float a0 = -(fmaxf(z0, 0.f) + lg2(1.f + ex2(-fabsf(z0)))), a1 = -(fmaxf(z1, 0.f) + lg2(1.f + ex2(-fabsf(z1))));
                    if (diag) { if (s >= trow) a0 = 0.f; if (s + 32 >= trow) a1 = 0.f; }
                    p0[i] = z0; p1[i] = z1; L0[i] = a0; L1[i] = a1; }
                float gs[8], pg[8];
#pragma unroll
                for (int g = 0; g < 4; ++g) { gs[g] = (L0[4 * g] + L0[4 * g + 1]) + (L0[4 * g + 2] + L0[4 * g + 3]); gs[4 + g] = (L1[4 * g] + L1[4 * g + 1]) + (L1[4 * g + 2] + L1[4 * g + 3]); }
#pragma unroll
                for (int g = 0; g < 8; ++g) pg[g] = __shfl_xor(gs[g], 32);
                float T = R;
#pragma unroll
                for (int G = 7; G >= 0; --G) {
                    const float off = T + (hi == 0 ? pg[G] : 0.f);
                    f32x16& LL = (G >= 4) ? L1 : L0; f32x16& PP = (G >= 4) ? p1 : p0; const int b4 = 4 * (G & 3);
                    const float a3 = off + LL[b4 + 3], a2 = a3 + LL[b4 + 2], a1 = a2 + LL[b4 + 1], a0 = a1 + LL[b4];
                    PP[b4 + 3] = ex2(PP[b4 + 3] + a3); PP[b4 + 2] = ex2(PP[b4 + 2] + a2); PP[b4 + 1] = ex2(PP[b4 + 1] + a1); PP[b4] = ex2(PP[b4] + a0);
                    T += gs[G] + pg[G];
                }
                R = T;
                if (diag) {
#pragma unroll
                    for (int i = 0; i < 16; ++i) { const int s = sb + (i & 3) + 8 * (i >> 2); if (s >= trow) p0[i] = 0.f; if (s + 32 >= trow) p1[i] = 0.f; }
                }
            }
            pb[0] = pack8(p0, 0); pb[1] = pack8(p0, 8); pb[2] = pack8(p1, 0); pb[3] = pack8(p1, 8);
            pv(o0, o1, Vb, pb, lane, hi);
        }
        if (more) { *(LAS u32x4*)(kst + (buf ^ 1) * KBUF) = kreg; *(LAS u32x4*)(vst + (buf ^ 1) * VBUF) = vreg; }
        __syncthreads();
    }
    float sc = 1.f;
    if (MODE == 0) { l += __shfl_xor(l, 32); sc = 1.f / l; }
    store_o(Og + (size_t)trow * DM, o0, o1, sc, hi);
}
}
namespace hg {
constexpr int P272 = 272, PKH = 144, PV = 320;
constexpr int H_QP = 0, H_QI = 17408, H_KT = 34816, H_KH = 52224, H_V = 70656, H_ST = 91136, H_BL = 125952, H_PART = 126464, H_RMS = 128512, H_END = 129536;
static_assert(H_END <= LDS_MISC, "hgrn LDS map");
constexpr int LDP = EVEN_N;

__device__ __forceinline__ void hgrn_unit(LAS char* lds, const bf16_t* proj, const float* lb3  , const float* norm_g, bf16_t* ycat, int b, int h) {
    const int tid = threadIdx.x, lane = tid & 63, r = lane & 31, hi = lane >> 5, w = __builtin_amdgcn_readfirstlane(tid >> 6);
    const int k = tid & 127, tq = tid >> 7;
    const int th = w >> 2, vs = w & 3;
    float lbk;
    { const float l0 = lb3[128 * h + k], l1 = lb3[512 + 128 * h + k], l2 = lb3[1024 + 128 * h + k]; const float mx = fmaxf(l0, fmaxf(l1, l2));
      const float e0 = expf(l0 - mx), e1 = expf(l1 - mx), e2 = expf(l2 - mx); lbk = e0 / (e0 + e1 + e2); }
    const bf16_t* base = proj + (size_t)(b * SEQ) * LDP + 128 * h;
    for (int i = tid; i < (128 * P272) / 16; i += 512) *(LAS u32x4*)(lds + H_ST + 16 * i) = (u32x4){0u, 0u, 0u, 0u};
    f32x16 s0 = f32x16{}, s1 = f32x16{};
    const int kt0 = 2 * (w >> 2), kt1 = kt0 + 1;
    LAS float* PART = (LAS float*)(lds + H_PART); LAS float* BL = (LAS float*)(lds + H_BL); LAS float* RMS = (LAS float*)(lds + H_RMS);
    float ngv[4][4];
#pragma unroll
    for (int g = 0; g < 4; ++g)
#pragma unroll
        for (int e = 0; e < 4; ++e) ngv[g][e] = norm_g[32 * vs + 8 * g + 4 * hi + e];
    const int vr0 = tid >> 4, vc = tid & 15;
    unsigned short qz[32]; u32x4 vreg[2];
#define HG_LOAD(c) do { const bf16_t* pb_ = base + (size_t)(64 * (c) + 16 * tq) * LDP + k; \
        _Pragma("unroll") for (int i = 0; i < 16; ++i) { qz[i] = pb_[(size_t)i * LDP]; qz[16 + i] = pb_[(size_t)i * LDP + 512]; } \
        _Pragma("unroll") for (int i = 0; i < 2; ++i) vreg[i] = *(const u32x4*)(base + (size_t)(64 * (c) + vr0 + 32 * i) * LDP + 1024 + 8 * vc); } while (0)
    HG_LOAD(0);
    for (int c = 0; c < SEQ / 64; ++c) {
        float Lc[16], kk[16], qv[16];
        float run = 0.f;
#pragma unroll
        for (int i = 0; i < 16; ++i) { const float z = bf2f(qz[16 + i]); qv[i] = bf2f(qz[i]);
            const float sg = frcp(1.f + ex2(-LOG2E * z)); const float f = lbk + (1.f - lbk) * sg;
            run += lg2(f); Lc[i] = run; kk[i] = (1.f - lbk) * (1.f - sg); }
        PART[tq * 128 + k] = run;
#pragma unroll
        for (int i = 0; i < 2; ++i) *(LAS u32x4*)(lds + H_V + (vr0 + 32 * i) * PV + vc * 16) = vreg[i];
        __syncthreads();
        const float pa = PART[k], pbb = PART[128 + k], pc = PART[256 + k], pd = PART[384 + k];
        const float pre = (tq > 0 ? pa : 0.f) + (tq > 1 ? pbb : 0.f) + (tq > 2 ? pc : 0.f);
        const float bmid = pa + pbb, blast = bmid + pc + pd;
        const float Emid = ex2(bmid), Elm = ex2(blast - bmid);
        if (tq == 0) BL[k] = ex2(blast);
        unsigned khp[8];
#pragma unroll
        for (int i = 0; i < 16; i += 2) {
            float e1a = ex2(pre + Lc[i] - bmid), e1b = ex2(pre + Lc[i + 1] - bmid);
            float e3a = ex2(bmid - pre - Lc[i]), e3b = ex2(bmid - pre - Lc[i + 1]);
            const int t = 16 * tq + i;
            const float qpa = qv[i] * e1a, qpb = qv[i + 1] * e1b, kta = kk[i] * e3a, ktb = kk[i + 1] * e3b;
            *(LAS bf16_t*)(lds + H_QP + t * P272 + k * 2) = (bf16_t)cvtpk(qpa, 0.f); *(LAS bf16_t*)(lds + H_QP + (t + 1) * P272 + k * 2) = (bf16_t)cvtpk(qpb, 0.f);
            *(LAS bf16_t*)(lds + H_QI + t * P272 + k * 2) = (bf16_t)cvtpk(qpa * Emid, 0.f); *(LAS bf16_t*)(lds + H_QI + (t + 1) * P272 + k * 2) = (bf16_t)cvtpk(qpb * Emid, 0.f);
            *(LAS bf16_t*)(lds + H_KT + t * P272 + k * 2) = (bf16_t)cvtpk(kta, 0.f); *(LAS bf16_t*)(lds + H_KT + (t + 1) * P272 + k * 2) = (bf16_t)cvtpk(ktb, 0.f);
            khp[i >> 1] = cvtpk(kta * Elm, ktb * Elm);
        }
        *(LAS u32x4*)(lds + H_KH + k * PKH + tq * 32) = (u32x4){khp[0], khp[1], khp[2], khp[3]};
        *(LAS u32x4*)(lds + H_KH + k * PKH + tq * 32 + 16) = (u32x4){khp[4], khp[5], khp[6], khp[7]};
        __syncthreads();
        if (c + 1 < SEQ / 64) HG_LOAD(c + 1);
        bf16x8 pb0[2], pb1[2];
        {
            f32x16 acc = f32x16{};
#pragma unroll
            for (int ks = 0; ks < 8; ++ks) { const bf16x8 a = *(const LAS bf16x8*)(lds + H_KT + r * P272 + (16 * ks + 8 * hi) * 2), bq = *(const LAS bf16x8*)(lds + H_QP + (32 * th + r) * P272 + (16 * ks + 8 * hi) * 2); acc = MFMA32(a, bq, acc); }
            if (th == 0) {
#pragma unroll
                for (int i = 0; i < 16; ++i) if (crow(i, hi) > r) acc[i] = 0.f;
            }
            pb0[0] = pack8(acc, 0); pb0[1] = pack8(acc, 8);
        }
        if (th == 1) {
            f32x16 acc = f32x16{};
#pragma unroll
            for (int ks = 0; ks < 8; ++ks) { const bf16x8 a = *(const LAS bf16x8*)(lds + H_KT + (32 + r) * P272 + (16 * ks + 8 * hi) * 2), bq = *(const LAS bf16x8*)(lds + H_QP + (32 + r) * P272 + (16 * ks + 8 * hi) * 2); acc = MFMA32(a, bq, acc); }
#pragma unroll
            for (int i = 0; i < 16; ++i) if (crow(i, hi) > r) acc[i] = 0.f;
            pb1[0] = pack8(acc, 0); pb1[1] = pack8(acc, 8);
        } else { pb1[0] = bf16x8{}; pb1[1] = bf16x8{}; }
        f32x16 o = f32x16{};
#pragma unroll
        for (int ks = 0; ks < 8; ++ks) { const bf16x8 a = *(const LAS bf16x8*)(lds + H_ST + (32 * vs + r) * P272 + (16 * ks + 8 * hi) * 2), bq = *(const LAS bf16x8*)(lds + H_QI + (32 * th + r) * P272 + (16 * ks + 8 * hi) * 2); o = MFMA32(a, bq, o); }
        const LAS char* vb = lds + H_V + (4 * hi + ((lane & 15) >> 2)) * PV + (32 * vs + 16 * ((lane >> 4) & 1) + 4 * (lane & 3)) * 2;
#pragma unroll
        for (int st = 0; st < 2; ++st) { const s16x4 lo = vtr(vb + (16 * st) * PV), hh = vtr(vb + (16 * st + 8) * PV);
            o = MFMA32(((bf16x8){lo[0], lo[1], lo[2], lo[3], hh[0], hh[1], hh[2], hh[3]}), pb0[st], o); }
        if (th == 1) {
#pragma unroll
            for (int st = 0; st < 2; ++st) { const s16x4 lo = vtr(vb + (32 + 16 * st) * PV), hh = vtr(vb + (32 + 16 * st + 8) * PV);
                o = MFMA32(((bf16x8){lo[0], lo[1], lo[2], lo[3], hh[0], hh[1], hh[2], hh[3]}), pb1[st], o); }
        }
        { float ss = 0.f;
#pragma unroll
          for (int i = 0; i < 16; ++i) ss += o[i] * o[i];
          ss += __shfl_xor(ss, 32);
          if (hi == 0) RMS[vs * 64 + 32 * th + r] = ss; }
        __syncthreads();
        { const int tl = 32 * th + r; const float tot = (RMS[tl] + RMS[64 + tl]) + (RMS[128 + tl] + RMS[192 + tl]);
          const float rstd = __builtin_amdgcn_rsqf(tot * (1.f / 128.f) + LN_EPS);
          const size_t row = (size_t)(b * SEQ + 64 * c + tl);
#pragma unroll
          for (int g = 0; g < 4; ++g) { const int v0 = 32 * vs + 8 * g + 4 * hi;
              const u32x2 gg = *(const u32x2*)(base + (size_t)(64 * c + tl) * LDP + 1536 + v0);
              const float g0 = bflo(gg.x), g1 = bfhi(gg.x), g2 = bflo(gg.y), g3 = bfhi(gg.y);
              const float y0 = o[4 * g] * rstd * ngv[g][0] * (g0 * frcp(1.f + ex2(-LOG2E * g0))), y1 = o[4 * g + 1] * rstd * ngv[g][1] * (g1 * frcp(1.f + ex2(-LOG2E * g1)));
              const float y2 = o[4 * g + 2] * rstd * ngv[g][2] * (g2 * frcp(1.f + ex2(-LOG2E * g2))), y3 = o[4 * g + 3] * rstd * ngv[g][3] * (g3 * frcp(1.f + ex2(-LOG2E * g3)));
              u32x2 wv; wv.x = cvtpk(y0, y1); wv.y = cvtpk(y2, y3);
              *(u32x2*)(ycat + row * DM + 128 * h + v0) = wv; } }
        { const float d0 = BL[32 * kt0 + r], d1 = BL[32 * kt1 + r];
#pragma unroll
          for (int i = 0; i < 16; ++i) { s0[i] *= d0; s1[i] *= d1; }
          const LAS char* vn = lds + H_V + (8 * hi + ((lane & 15) >> 2)) * PV + (32 * vs + 16 * ((lane >> 4) & 1) + 4 * (lane & 3)) * 2;
#pragma unroll
          for (int st = 0; st < 4; ++st) { const s16x4 lo = vtr(vn + (16 * st) * PV), hh = vtr(vn + (16 * st + 4) * PV);
              const bf16x8 a = (bf16x8){lo[0], lo[1], lo[2], lo[3], hh[0], hh[1], hh[2], hh[3]};
              const bf16x8 b0 = *(const LAS bf16x8*)(lds + H_KH + (32 * kt0 + r) * PKH + (16 * st + 8 * hi) * 2), b1 = *(const LAS bf16x8*)(lds + H_KH + (32 * kt1 + r) * PKH + (16 * st + 8 * hi) * 2);
              s0 = MFMA32(a, b0, s0); s1 = MFMA32(a, b1, s1); }
#pragma unroll
          for (int i = 0; i < 16; ++i) { const int v = 32 * vs + crow(i, hi);
              *(LAS bf16_t*)(lds + H_ST + v * P272 + (32 * kt0 + r) * 2) = (bf16_t)cvtpk(s0[i], 0.f); *(LAS bf16_t*)(lds + H_ST + v * P272 + (32 * kt1 + r) * 2) = (bf16_t)cvtpk(s1[i], 0.f); } }
        __syncthreads();
    }
#undef HG_LOAD
}
}
namespace lru {
constexpr int L_XC = 0, L_CW = 8 * 32 * 65 * 4  , L_CB = L_CW + 4 * 64 * 4, L_AS = L_CB + 256, L_HS = L_AS + 8 * 64 * 4, L_END = L_HS + 8 * 64 * 4;
static_assert(L_END <= LDS_MISC, "lru LDS map");
constexpr int LDP = ODD_IN;
__device__ __forceinline__ float gelu_tanh(float x) { const float y = 0.7978845608028654f * (x + 0.044715f * x * x * x); const float t = 1.f - 2.f * frcp(1.f + ex2(2.f * LOG2E * y)); return 0.5f * x * (1.f + t); }

__device__ __forceinline__ void lru_unit(LAS char* lds, const bf16_t* proj, const float* conv_w, const float* conv_b, const float* wa, const float* ba, const float* wx, const float* bx, const float* lam,
                                         float* abuf, float* ubuf, bf16_t* ycat, int b, int n) {
    const int tid = threadIdx.x, lane = tid & 63, r = lane & 31, hi = lane >> 5, w = __builtin_amdgcn_readfirstlane(tid >> 6);
    const int ch0 = 64 * n;
    LAS float* CW = (LAS float*)(lds + L_CW); LAS float* CB = (LAS float*)(lds + L_CB); LAS float* XC = (LAS float*)(lds + L_XC) + w * (32 * 65);
    LAS float* AS = (LAS float*)(lds + L_AS); LAS float* HS = (LAS float*)(lds + L_HS);
    if (tid < 256) CW[tid] = conv_w[(tid >> 6) * 512 + ch0 + (tid & 63)]; else if (tid < 320) CB[tid - 256] = conv_b[ch0 + tid - 256];
    bf16x8 waf[2][4], wxf[2][4];
#pragma unroll
    for (int nt = 0; nt < 2; ++nt)
#pragma unroll
        for (int ks = 0; ks < 4; ++ks) { float va[8], vx[8];
#pragma unroll
            for (int e = 0; e < 8; ++e) { const size_t off = ((size_t)n * 64 + 16 * ks + 8 * hi + e) * 64 + 32 * nt + r; va[e] = wa[off]; vx[e] = wx[off]; }
            u32x4 pa, px; pa.x = cvtpk(va[0], va[1]); pa.y = cvtpk(va[2], va[3]); pa.z = cvtpk(va[4], va[5]); pa.w = cvtpk(va[6], va[7]);
            px.x = cvtpk(vx[0], vx[1]); px.y = cvtpk(vx[2], vx[3]); px.z = cvtpk(vx[4], vx[5]); px.w = cvtpk(vx[6], vx[7]);
            waf[nt][ks] = __builtin_bit_cast(bf16x8, pa); wxf[nt][ks] = __builtin_bit_cast(bf16x8, px); }
    float bav[2], bxv[2], csv[2];
#pragma unroll
    for (int nt = 0; nt < 2; ++nt) { const int c = ch0 + 32 * nt + r; bav[nt] = ba[c]; bxv[nt] = bx[c]; csv[nt] = 8.0f * log1pf(expf(-lam[c])); }
    __syncthreads();
    const bf16_t* pbase = proj + (size_t)(b * SEQ) * LDP + ch0;
    for (int tt = w; tt < SEQ / 32; tt += 8) {
        const int t0 = 32 * tt, trow = t0 + r;
        bf16x8 af[4];
#pragma unroll
        for (int ks = 0; ks < 4; ++ks) { const int c8 = 16 * ks + 8 * hi; float acc[8];
#pragma unroll
            for (int e = 0; e < 8; ++e) acc[e] = CB[c8 + e];
#pragma unroll
            for (int j = 0; j < 4; ++j) { const int tj = trow - 3 + j;
                if (tj >= 0) { const u32x4 xv = *(const u32x4*)(pbase + (size_t)tj * LDP + c8);
                    acc[0] += CW[j * 64 + c8] * bflo(xv.x); acc[1] += CW[j * 64 + c8 + 1] * bfhi(xv.x); acc[2] += CW[j * 64 + c8 + 2] * bflo(xv.y); acc[3] += CW[j * 64 + c8 + 3] * bfhi(xv.y);
                    acc[4] += CW[j * 64 + c8 + 4] * bflo(xv.z); acc[5] += CW[j * 64 + c8 + 5] * bfhi(xv.z); acc[6] += CW[j * 64 + c8 + 6] * bflo(xv.w); acc[7] += CW[j * 64 + c8 + 7] * bfhi(xv.w); } }
#pragma unroll
            for (int e = 0; e < 8; ++e) XC[r * 65 + c8 + e] = acc[e];
            u32x4 pk; pk.x = cvtpk(acc[0], acc[1]); pk.y = cvtpk(acc[2], acc[3]); pk.z = cvtpk(acc[4], acc[5]); pk.w = cvtpk(acc[6], acc[7]);
            af[ks] = __builtin_bit_cast(bf16x8, pk); }
        f32x16 ra0 = f32x16{}, ra1 = f32x16{}, rx0 = f32x16{}, rx1 = f32x16{};
#pragma unroll
        for (int ks = 0; ks < 4; ++ks) { ra0 = MFMA32(af[ks], waf[0][ks], ra0); ra1 = MFMA32(af[ks], waf[1][ks], ra1); rx0 = MFMA32(af[ks], wxf[0][ks], rx0); rx1 = MFMA32(af[ks], wxf[1][ks], rx1); }
        asm volatile("s_waitcnt lgkmcnt(0)" ::: "memory");
#pragma unroll
        for (int nt = 0; nt < 2; ++nt)
#pragma unroll
            for (int i = 0; i < 16; ++i) { const int tl = crow(i, hi); const float xcv = XC[tl * 65 + 32 * nt + r];
                const float rp = (nt ? ra1[i] : ra0[i]) + bav[nt], ip = (nt ? rx1[i] : rx0[i]) + bxv[nt];
                const float rg = frcp(1.f + ex2(-LOG2E * rp)), ig = frcp(1.f + ex2(-LOG2E * ip));
                const float la = -rg * csv[nt];
                const float av = expf(la), uv = sqrtf(-expm1f(2.f * la)) * (ig * xcv);
                const size_t o = (size_t)(b * SEQ + t0 + tl) * 512 + ch0 + 32 * nt + r;
                abuf[o] = av; ubuf[o] = uv; }
    }
    __threadfence_block();
    asm volatile("s_waitcnt vmcnt(0)" ::: "memory");
    __syncthreads();
    const size_t sbase = (size_t)(b * SEQ + 256 * w) * 512 + ch0 + lane;
    { float A = 1.f, Hh = 0.f;
      for (int t = 0; t < 256; t += 8) { float av[8], uv[8];
#pragma unroll
          for (int e = 0; e < 8; ++e) { av[e] = abuf[sbase + (size_t)(t + e) * 512]; uv[e] = ubuf[sbase + (size_t)(t + e) * 512]; }
#pragma unroll
          for (int e = 0; e < 8; ++e) { Hh = av[e] * Hh + uv[e]; A *= av[e]; } }
      AS[w * 64 + lane] = A; HS[w * 64 + lane] = Hh; }
    __syncthreads();
    float hst = 0.f;
#pragma unroll
    for (int ww = 0; ww < 8; ++ww) if (ww < w) hst = AS[ww * 64 + lane] * hst + HS[ww * 64 + lane];
    const bf16_t* gptr = proj + (size_t)(b * SEQ + 256 * w) * LDP + 512 + ch0 + lane;
    bf16_t* optr = ycat + (size_t)(b * SEQ + 256 * w) * DM + ch0 + lane;
    for (int t = 0; t < 256; t += 8) { float av[8], uv[8]; unsigned short gv[8];
#pragma unroll
        for (int e = 0; e < 8; ++e) { av[e] = abuf[sbase + (size_t)(t + e) * 512]; uv[e] = ubuf[sbase + (size_t)(t + e) * 512]; gv[e] = gptr[(size_t)(t + e) * LDP]; }
#pragma unroll
        for (int e = 0; e < 8; ++e) { hst = av[e] * hst + uv[e]; optr[(size_t)(t + e) * DM] = (bf16_t)cvtpk(hst * gelu_tanh(bf2f(gv[e])), 0.f); } }
    __syncthreads();
}
}
#ifndef TG
#define TG 15
#endif
#ifndef TM
#define TM 255
#endif
#ifndef PROBE_MASK
#define PROBE_MASK 0
#endif
#ifndef MK_SINGLE
#define MK_SINGLE 1
#endif
constexpr int N_PHASES = 15;
struct Args { const float* in[19]; float* out; unsigned char* ws; int ph_lo, ph_hi; };
typedef const __attribute__((address_space(4))) Args* KArgs;
__device__ __forceinline__ KArgs kargs() { KArgs kp = (KArgs)__builtin_amdgcn_kernarg_segment_ptr(); asm volatile("" : "+s"(kp)); return kp; }

template <class Epi, bool ALIGN, int GBIT>
__device__ __forceinline__ void run_gemm(LAS unsigned char* lds, const bf16_t* A, const bf16_t* Bt, int N, int K, const Epi& E) {
    pg8::Gemm g{A, Bt, MROWS, N, K}; pg8::StaticOrder S; S.init(MROWS, N, (int)gridDim.x, (int)blockIdx.x);
#if TM & 32
    if (TG & GBIT) pg8::gemm_phase<Epi, pg8::StaticOrder, ALIGN, true>(lds, g, S, E);
#endif
}

template <int LAYER>
__device__ __forceinline__ void mixer_phase(LAS unsigned char* lds) {
    const int tid = threadIdx.x;
    LAS int* slot = (LAS int*)(lds + LDS_MISC);
    constexpr int nfirst = LAYER == 0 ? 32 : 64;
    for (int rep = 0; rep < 1 + ((PROBE_MASK >> (2 * LAYER)) & 1); ++rep)
    {
        KArgs k = kargs(); unsigned char* ws = k->ws; unsigned* ctr = (unsigned*)(ws + WS_CTL) + 64 + 128 * LAYER + 16 * rep;
        for (;;) {
            __syncthreads(); if (tid == 0) *slot = (int)atomicAdd(ctr, 1u); __syncthreads();
            const int u = *slot; if (u >= nfirst) break;
#if TM & 2
            if (LAYER == 0) hg::hgrn_unit((LAS char*)lds, (const bf16_t*)(ws + WS_PROJ), k->in[3], k->in[4], (bf16_t*)(ws + WS_YCAT), u >> 2, u & 3);
#endif
#if TM & 4
            if (LAYER == 1) lru::lru_unit((LAS char*)lds, (const bf16_t*)(ws + WS_PROJ), k->in[7], k->in[8], k->in[9], k->in[10], k->in[11], k->in[12], k->in[13], (float*)(ws + WS_XB), (float*)(ws + WS_LRU_U), (bf16_t*)(ws + WS_YCAT), u >> 3, u & 7);
#endif
        }
    }
    for (int rep = 0; rep < 1 + ((PROBE_MASK >> (2 * LAYER + 1)) & 1); ++rep)
    {
        KArgs k = kargs(); unsigned char* ws = k->ws; unsigned* ctr = (unsigned*)(ws + WS_CTL) + 128 + 128 * LAYER + 16 * rep;
        for (;;) {
            __syncthreads(); if (tid == 0) *slot = (int)atomicAdd(ctr, 1u); __syncthreads();
            const int i = *slot; if (i >= 512) break;
            const int qb = 7 - (i >> 6), bh = i & 63, b = bh >> 3, h = bh & 7;
            bf16_t* Og = (bf16_t*)(ws + WS_YCAT) + (size_t)(b * SEQ) * DM + 512 + 64 * h;
#if TM & 8
            if (LAYER == 0) { const bf16_t* pr = (const bf16_t*)(ws + WS_PROJ) + (size_t)(b * SEQ) * EVEN_N + 64 * h;
                att::attn_unit<0>((LAS char*)lds, pr + 2048, pr + 2560, pr + 3072, EVEN_N, (const float*)(ws + WS_FB) + (size_t)(b * SEQ) * 8 + h, k->in[2][h], Og, qb); }
#endif
#if TM & 16
            if (LAYER == 1) { const bf16_t* pr = (const bf16_t*)(ws + WS_PROJ) + (size_t)(b * SEQ) * ODD_IN + 64 * h;
                att::attn_unit<1>((LAS char*)lds, pr + 1024, pr + 1536, pr + 2048, ODD_IN, nullptr, 0.f, Og, qb); }
#endif
        }
    }
}

template <int LAYER>
__device__ __forceinline__ void layer_phases(LAS unsigned char* lds, const XcdBarrier& bar, int lo, int hi, int gw, int NGW, int lane) {
#define IN(k) (lo <= (k) && (k) < hi)
#define SEAM(k) do { if (IN(k) && IN((k) + 1)) xcd_barrier(bar); } while (0)
    constexpr int pb = 1 + 7 * LAYER;
    if (IN(pb)) { KArgs k = kargs(); unsigned char* ws = k->ws;
        pg8::EpiBf16<0> E{(bf16_t*)(ws + WS_PROJ), LAYER == 0 ? EVEN_N : ODD_IN, nullptr, 0, 0, 1.f};
        for (int rep = 0; rep < 1 + ((PROBE_MASK >> (4 + LAYER)) & 1); ++rep)
        run_gemm<pg8::EpiBf16<0>, true, 1>(lds, (const bf16_t*)(ws + WS_XB), (const bf16_t*)(ws + (LAYER == 0 ? WS_WIN0 : WS_WIN1)), LAYER == 0 ? EVEN_N : ODD_IN, DM, E); }
    SEAM(pb);
    if (IN(pb + 1)) mixer_phase<LAYER>(lds);
    SEAM(pb + 1);
    if (IN(pb + 2)) { KArgs k = kargs(); unsigned char* ws = k->ws;
        pg8::EpiResid E{LAYER == 0 ? k->in[0] : (const float*)k->out, k->out, DM, ALPHA};
        run_gemm<pg8::EpiResid, false, 2>(lds, (const bf16_t*)(ws + WS_YCAT), (const bf16_t*)(ws + (LAYER == 0 ? WS_WOUT0 : WS_WOUT1)), DM, DM, E); }
    SEAM(pb + 2);
    if (IN(pb + 3)) { KArgs k = kargs(); phase_ln(k->out, k->out, (bf16_t*)(k->ws + WS_XB), k->in[17] + (LAYER * 2) * DM, k->in[18] + (LAYER * 2) * DM, gw, NGW, lane); }
    SEAM(pb + 3);
    if (IN(pb + 4)) { KArgs k = kargs(); unsigned char* ws = k->ws;
        pg8::EpiSwiGLU E{(bf16_t*)(ws + WS_PROJ), DFF};
        for (int rep = 0; rep < 1 + ((PROBE_MASK >> (6 + LAYER)) & 1); ++rep)
        run_gemm<pg8::EpiSwiGLU, true, 4>(lds, (const bf16_t*)(ws + WS_XB), (const bf16_t*)(ws + WS_W13 + LAYER * W13_BYTES), DFF2, DM, E); }
    SEAM(pb + 4);
    if (IN(pb + 5)) { KArgs k = kargs(); unsigned char* ws = k->ws;
        pg8::EpiResid E{(const float*)k->out, k->out, DM, ALPHA};
        run_gemm<pg8::EpiResid, false, 8>(lds, (const bf16_t*)(ws + WS_PROJ), (const bf16_t*)(ws + WS_W2 + LAYER * W2_BYTES), DM, DFF, E); }
    SEAM(pb + 5);
    if (IN(pb + 6)) { KArgs k = kargs(); phase_ln(k->out, k->out, LAYER == 0 ? (bf16_t*)(k->ws + WS_XB) : nullptr, k->in[17] + (LAYER * 2 + 1) * DM, k->in[18] + (LAYER * 2 + 1) * DM, gw, NGW, lane); }
    if (LAYER == 0) SEAM(pb + 6);
#undef IN
#undef SEAM
}

__global__ void __launch_bounds__(512, 2) mega_fwd(Args args) {
    extern __shared__ __attribute__((aligned(16))) unsigned char lds_raw[];
    LAS unsigned char* lds = (LAS unsigned char*)lds_raw;
    const int tid = threadIdx.x, lane = tid & 63, wave = __builtin_amdgcn_readfirstlane(tid >> 6);
    const int gw = blockIdx.x * 8 + wave, NGW = gridDim.x * 8;
    const int lo = args.ph_lo, hi = args.ph_hi;
    if (tid < 64) ((LAS unsigned*)(lds + LDS_MISC))[tid] = 0u;
    __syncthreads();
    XcdBarrier bar; bar.bar = nullptr; bar.x = 0; bar.st = nullptr;
    if (hi - lo > 1) { KArgs k = kargs(); bar = xcd_barrier_post((unsigned*)(k->ws + WS_CTL) + 1024, (volatile LAS unsigned*)(lds + LDS_MISC + 64)); }
#if TM & 1
    if (lo <= 0 && 0 < hi) { KArgs k = kargs(); P p{k->in[0], k->in[1], k->in[5], k->in[6], k->in[14], k->in[15], k->in[16], k->ws}; phase_prologue(p, lds, gw, NGW, wave, lane, tid);
        if (PROBE_MASK & 256) { __syncthreads(); phase_prologue(p, lds, gw, NGW, wave, lane, tid); }
        if (PROBE_MASK & 1024) { phase_ln(k->in[0], (float*)(k->ws + WS_PROJ), (bf16_t*)(k->ws + WS_YCAT), k->in[17], k->in[18], gw, NGW, lane); } }
#endif
    if (PROBE_MASK & 512) { for (int i = 0; i < 10; ++i) xcd_barrier(bar); }
    if (lo <= 0 && 1 < hi) xcd_barrier(bar);
    layer_phases<0>(lds, bar, lo, hi, gw, NGW, lane);
    layer_phases<1>(lds, bar, lo, hi, gw, NGW, lane);
    if (hi > 1000) cg::this_grid().sync();
}

extern "C" void kernel_launch(void* const* d_in, const int* in_sizes, int n_in, void* d_out, int out_size, void* d_ws, size_t ws_size, hipStream_t stream) {
    static int grid = 0;
    if (grid == 0) {
        if (n_in != 19 || out_size != MROWS * DM || ws_size < WS_END) { fprintf(stderr, "kernel_launch: unexpected shapes (n_in %d out %d ws %zu)\n", n_in, out_size, ws_size); grid = -1; return; }
        int dev = 0, cus = 0, per_cu = 0;
        (void)hipGetDevice(&dev); (void)hipDeviceGetAttribute(&cus, hipDeviceAttributeMultiprocessorCount, dev);
        if (hipFuncSetAttribute((const void*)mega_fwd, hipFuncAttributeMaxDynamicSharedMemorySize, LDS_BYTES) != hipSuccess) { fprintf(stderr, "kernel_launch: hipFuncSetAttribute failed\n"); }
        if (hipOccupancyMaxActiveBlocksPerMultiprocessor(&per_cu, (const void*)mega_fwd, 512, LDS_BYTES) != hipSuccess || per_cu < 1) per_cu = 1;
        (void)hipGetLastError();
        grid = cus * per_cu; if (grid <= 0) grid = 256;
    }
    if (grid < 0) return;
    (void)hipMemsetAsync((char*)d_ws + WS_CTL, 0, CTL_ZERO_BYTES, stream);
    Args a{};
    for (int i = 0; i < 19; ++i) a.in[i] = (const float*)d_in[i];
    a.out = (float*)d_out; a.ws = (unsigned char*)d_ws;
#if MK_SINGLE
    a.ph_lo = 0; a.ph_hi = N_PHASES;
    void* kargs_[] = {&a};
    hipError_t e = hipLaunchCooperativeKernel((const void*)mega_fwd, dim3(grid), dim3(512), kargs_, LDS_BYTES, stream);
    if (e != hipSuccess) fprintf(stderr, "cooperative launch failed: %s (grid %d)\n", hipGetErrorString(e), grid);
#else
    for (int ph = 0; ph < N_PHASES; ++ph) { a.ph_lo = ph; a.ph_hi = ph + 1; hipLaunchKernelGGL(mega_fwd, dim3(grid), dim3(512), LDS_BYTES, stream, a); }
#endif
}
```
